# Optimizing an MI355X kernel written in HIP

```python
import jax, jax.numpy as jnp
from jax import lax
import numpy as np

D_MODEL = 1024
BATCH = 1
SEQ = 16384
DEPTH = 4

GLA_HEADS = 4
GLA_DK_HEAD = 64
GLA_DV_HEAD = 128
GLA_DK = GLA_HEADS * GLA_DK_HEAD
GLA_DV = GLA_HEADS * GLA_DV_HEAD
GLA_GATE_RANK = 16
GLA_GATE_TAU = 16.0
GLA_CHUNK = 64
SWA_Q_HEADS = 8
SWA_KV_HEADS = 2
SWA_HEAD_DIM = 64
SWA_WINDOW = 128
SWA_BLOCK = 128
SWA_Q_DIM = SWA_Q_HEADS * SWA_HEAD_DIM
SWA_KV_DIM = SWA_KV_HEADS * SWA_HEAD_DIM
POOL_GROUPS = 4
POOL_GROUP_DIM = 128
POOL_DIM = POOL_GROUPS * POOL_GROUP_DIM
POOL_WINDOWS = (2, 4, 8, 16)
N_BRANCHES = 3
D_FF = 2816
CONV_WIDTH = 3
RMS_EPS = 1e-6

SPLIT_SIZES = (GLA_DK, GLA_DK, GLA_DV, GLA_GATE_RANK, GLA_DV,
               SWA_Q_DIM, SWA_KV_DIM, SWA_KV_DIM,
               POOL_DIM,
               N_BRANCHES * D_MODEL)
N_IN = sum(SPLIT_SIZES)
SPLIT_POINTS = tuple(int(v) for v in np.cumsum(SPLIT_SIZES)[:-1])

kernel_name = "hybrid_gla_swa_pool_gated_convffn"


def rmsnorm(x, gain):
    xf = x.astype(jnp.float32)
    var = jnp.mean(xf * xf, axis=-1, keepdims=True)
    return (xf * lax.rsqrt(var + RMS_EPS) * gain.astype(jnp.float32)).astype(x.dtype)


def gla_mixer(q, k, v, gate_low, r, w_gate_up, b_gate, norm_gain):
    f32 = jnp.float32
    B, T, _ = q.shape
    nc = T // GLA_CHUNK
    logit = gate_low.astype(f32) @ w_gate_up.astype(f32) + b_gate.astype(f32)
    log_alpha = jax.nn.log_sigmoid(logit) / GLA_GATE_TAU

    def to_chunks(t, d):
        return t.astype(f32).reshape(B, nc, GLA_CHUNK, GLA_HEADS, d).transpose(1, 0, 3, 2, 4)

    qc = to_chunks(q, GLA_DK_HEAD) * (GLA_DK_HEAD ** -0.5)
    kc = to_chunks(k, GLA_DK_HEAD)
    vc = to_chunks(v, GLA_DV_HEAD)
    gc = to_chunks(log_alpha, GLA_DK_HEAD)
    causal = jnp.tril(jnp.ones((GLA_CHUNK, GLA_CHUNK), dtype=bool))

    def step(S, inp):
        qi, ki, vi, gi = inp
        b = jnp.cumsum(gi, axis=2)
        diff = b[:, :, :, None, :] - b[:, :, None, :, :]
        decay = jnp.exp(jnp.where(causal[None, None, :, :, None], diff, -jnp.inf))
        attn = jnp.einsum('bhid,bhjd,bhijd->bhij', qi, ki, decay)
        o = jnp.einsum('bhij,bhjv->bhiv', attn, vi) \
            + jnp.einsum('bhid,bhdv->bhiv', qi * jnp.exp(b), S)
        b_last = b[:, :, -1:, :]
        S_new = jnp.exp(b_last[:, :, 0, :])[..., None] * S \
            + jnp.einsum('bhjd,bhjv->bhdv', ki * jnp.exp(b_last - b), vi)
        return S_new, o

    S0 = jnp.zeros((B, GLA_HEADS, GLA_DK_HEAD, GLA_DV_HEAD), f32)
    _, o = lax.scan(step, S0, (qc, kc, vc, gc))
    o = o.transpose(1, 0, 3, 2, 4).reshape(B, T, GLA_HEADS, GLA_DV_HEAD)
    var = jnp.mean(o * o, axis=-1, keepdims=True)
    o = o * lax.rsqrt(var + RMS_EPS) * norm_gain.astype(f32).reshape(GLA_HEADS, GLA_DV_HEAD)
    o = o.reshape(B, T, GLA_DV) * jax.nn.silu(r.astype(f32))
    return o.astype(q.dtype)


def swa_mixer(q, k, v, sinks):
    f32 = jnp.float32
    B, T, _ = q.shape
    nb = T // SWA_BLOCK
    G = SWA_Q_HEADS // SWA_KV_HEADS
    qb = q.astype(f32).reshape(B, nb, SWA_BLOCK, SWA_KV_HEADS, G, SWA_HEAD_DIM) * (SWA_HEAD_DIM ** -0.5)
    kb = k.astype(f32).reshape(B, nb, SWA_BLOCK, SWA_KV_HEADS, SWA_HEAD_DIM)
    vb = v.astype(f32).reshape(B, nb, SWA_BLOCK, SWA_KV_HEADS, SWA_HEAD_DIM)

    def with_prev(t):
        prev = jnp.concatenate([jnp.zeros_like(t[:, :1]), t[:, :-1]], axis=1)
        return jnp.concatenate([prev, t], axis=2)

    kw, vw = with_prev(kb), with_prev(vb)
    s = jnp.einsum('bnqhgd,bnkhd->bnhgqk', qb, kw)
    blk = jnp.arange(nb)[:, None, None] * SWA_BLOCK
    q_pos = blk + jnp.arange(SWA_BLOCK)[None, :, None]
    k_pos = blk - SWA_BLOCK + jnp.arange(2 * SWA_BLOCK)[None, None, :]
    valid = (k_pos <= q_pos) & (q_pos - k_pos < SWA_WINDOW) & (k_pos >= 0)
    s = jnp.where(valid[None, :, None, None], s, -jnp.inf)
    sink = sinks.astype(f32).reshape(1, 1, SWA_KV_HEADS, G, 1, 1)
    m = jnp.maximum(jnp.max(s, axis=-1, keepdims=True), sink)
    p = jnp.exp(s - m)
    denom = jnp.sum(p, axis=-1, keepdims=True) + jnp.exp(sink - m)
    o = jnp.einsum('bnhgqk,bnkhd->bnqhgd', p / denom, vw)
    return o.reshape(B, T, SWA_Q_DIM).astype(q.dtype)


def pool_mixer(u, w_group, scale):
    f32 = jnp.float32
    B, T, _ = u.shape
    uf = u.astype(f32)
    cs = jnp.cumsum(uf, axis=1)
    pos = jnp.arange(1, T + 1, dtype=f32)
    means = []
    for g, w in enumerate(POOL_WINDOWS):
        cg = cs[..., g * POOL_GROUP_DIM:(g + 1) * POOL_GROUP_DIM]
        shifted = jnp.pad(cg, ((0, 0), (w, 0), (0, 0)))[:, :T]
        cnt = jnp.minimum(pos, float(w))
        means.append((cg - shifted) / cnt[None, :, None])
    pooled = jnp.stack(means, axis=2)
    d = pooled - uf.reshape(B, T, POOL_GROUPS, POOL_GROUP_DIM)
    y = jnp.einsum('btgc,gcd->btgd', d, w_group.astype(f32)).reshape(B, T, POOL_DIM)
    return (y * scale.astype(f32)).astype(u.dtype)


def conv_ffn(h, w_up, conv_w, conv_b, w_down):
    T = h.shape[1]
    up = h @ w_up
    padded = jnp.pad(up, ((0, 0), (CONV_WIDTH - 1, 0), (0, 0)))
    conv = conv_b + conv_w[0] * padded[:, 0:T]
    for i in range(1, CONV_WIDTH):
        conv = conv + conv_w[i] * padded[:, i:i + T]
    gate, val = jnp.split(conv, 2, axis=-1)
    return (jax.nn.gelu(gate, approximate=True) * val) @ w_down


def setup_inputs(seed: int = 0) -> dict:
    key = jax.random.key(seed)
    ks = jax.random.split(key, 20)
    L = DEPTH

    def nrm(k, shape, scale):
        return jax.random.normal(k, shape, jnp.float32) * scale

    return {
        "x": nrm(ks[0], (BATCH, SEQ, D_MODEL), 1.0),
        "norm_mix_pre": 1.0 + nrm(ks[1], (L, D_MODEL), 0.05),
        "norm_mix_post": 1.0 + nrm(ks[2], (L, D_MODEL), 0.05),
        "norm_ffn_pre": 1.0 + nrm(ks[3], (L, D_MODEL), 0.05),
        "norm_ffn_post": 1.0 + nrm(ks[4], (L, D_MODEL), 0.05),
        "w_in": nrm(ks[5], (L, D_MODEL, N_IN), D_MODEL ** -0.5),
        "gla_w_gate_up": nrm(ks[6], (L, GLA_GATE_RANK, GLA_DK), GLA_GATE_RANK ** -0.5),
        "gla_b_gate": nrm(ks[7], (L, GLA_DK), 0.1),
        "gla_norm": 1.0 + nrm(ks[8], (L, GLA_DV), 0.05),
        "swa_sinks": nrm(ks[9], (L, SWA_Q_HEADS), 0.5),
        "pool_w": nrm(ks[10], (L, POOL_GROUPS, POOL_GROUP_DIM, POOL_GROUP_DIM), POOL_GROUP_DIM ** -0.5),
        "pool_scale": 1.0 + nrm(ks[11], (L, POOL_DIM), 0.05),
        "w_branch_gla": nrm(ks[12], (L, GLA_DV, D_MODEL), GLA_DV ** -0.5),
        "w_branch_swa": nrm(ks[13], (L, SWA_Q_DIM, D_MODEL), SWA_Q_DIM ** -0.5),
        "w_branch_pool": nrm(ks[14], (L, POOL_DIM, D_MODEL), POOL_DIM ** -0.5),
        "w_out": nrm(ks[15], (L, D_MODEL, D_MODEL), D_MODEL ** -0.5),
        "ffn_w_up": nrm(ks[16], (L, D_MODEL, 2 * D_FF), D_MODEL ** -0.5),
        "ffn_conv_w": nrm(ks[17], (L, CONV_WIDTH, 2 * D_FF), CONV_WIDTH ** -0.5),
        "ffn_conv_b": nrm(ks[18], (L, 2 * D_FF), 0.01),
        "ffn_w_down": nrm(ks[19], (L, D_FF, D_MODEL), D_FF ** -0.5),
    }


def reference(x, norm_mix_pre, norm_mix_post, norm_ffn_pre, norm_ffn_post, w_in,
              gla_w_gate_up, gla_b_gate, gla_norm, swa_sinks, pool_w, pool_scale,
              w_branch_gla, w_branch_swa, w_branch_pool, w_out,
              ffn_w_up, ffn_conv_w, ffn_conv_b, ffn_w_down):
    B, T, _ = x.shape
    for l in range(DEPTH):
        h = rmsnorm(x, norm_mix_pre[l])
        proj = h @ w_in[l]
        (g_q, g_k, g_v, g_low, g_r, s_q, s_k, s_v, p_u, gates) = jnp.split(proj, SPLIT_POINTS, axis=-1)
        y_a = gla_mixer(g_q, g_k, g_v, g_low, g_r, gla_w_gate_up[l], gla_b_gate[l], gla_norm[l]) @ w_branch_gla[l]
        y_b = swa_mixer(s_q, s_k, s_v, swa_sinks[l]) @ w_branch_swa[l]
        y_c = pool_mixer(p_u, pool_w[l], pool_scale[l]) @ w_branch_pool[l]
        gate = jax.nn.sigmoid(gates.reshape(B, T, N_BRANCHES, D_MODEL))
        merged = gate[:, :, 0] * y_a + gate[:, :, 1] * y_b + gate[:, :, 2] * y_c
        x = x + rmsnorm(merged @ w_out[l], norm_mix_post[l])
        h = rmsnorm(x, norm_ffn_pre[l])
        f = conv_ffn(h, ffn_w_up[l], ffn_conv_w[l], ffn_conv_b[l], ffn_w_down[l])
        x = x + rmsnorm(f, norm_ffn_post[l])
    return x
```

```cpp
#include <hip/hip_runtime.h>
#include <hip/hip_cooperative_groups.h>
#include <cstdio>
#include <cstdint>
namespace cg = cooperative_groups;
namespace pg8 {
#define PG8_LAS __attribute__((address_space(3)))
typedef unsigned short bf16_t;
typedef short bf16x8 __attribute__((ext_vector_type(8)));
typedef float f32x4 __attribute__((ext_vector_type(4)));
typedef unsigned u32x4 __attribute__((ext_vector_type(4)));
constexpr int BM = 256, BK = 64, HALF = 128, HTB = HALF * BK * 2  , STAGE_BYTES = 8 * HTB, NXCD = 8, WGM = 8;

__host__ __device__ __forceinline__ int lds_byte(int r, int c) { const int st = (r >> 4) * 2 + (c >> 5), rr = r & 15, cc = c & 31, ob = rr * 64 + cc * 2; return st * 1024 + (ob ^ (((ob >> 9) & 1) << 5)); }
__host__ __device__ __forceinline__ void stage_rc(int b, int& R, int& C) { const int st = b / 1024, sb = b % 1024, swz = sb ^ (((sb >> 9) & 1) << 5); R = (st >> 1) * 16 + swz / 64; C = (st & 1) * 32 + (swz % 64) / 2; }
__host__ __device__ __forceinline__ int perm32(int rho) { const int n = rho >> 4, i = rho & 15; return 8 * (i >> 2) + 4 * n + (i & 3); }

struct Unit { int pm, pn; };
struct Gemm { const bf16_t* A; const bf16_t* Bt; int M, N, K; int a_rows; };

struct StaticOrder {
    int nM, nN, nwg, G, c;
    __host__ __device__ void init(int M, int N, int G_, int c_) { nM = M / BM; nN = N / BM; nwg = nM * nN; G = G_; c = c_; tri = 0; }
    int tri;
    __host__ __device__ bool next(int i_, Unit& u) const {
        const int i = tri ? 0 : i_; if (tri && i_ >= 3) return false;
        const long L = (long)i * G + c; if (L >= nwg) return false;
        int wgid = (int)L; { const int q = nwg / NXCD, r = nwg % NXCD, xcd = wgid % NXCD, off = wgid / NXCD; wgid = (xcd < r ? xcd * (q + 1) : r * (q + 1) + (xcd - r) * q) + off; }
        const int nig = WGM * nN, gid = wgid / nig, fm = gid * WGM, gsz = (nM - fm) < WGM ? (nM - fm) : WGM;
        u.pm = fm + ((wgid % nig) % gsz); u.pn = (wgid % nig) / gsz; if (tri) { u.pm += 64 * i_; u.pn += 4 * i_; } return true;
    }
    __device__ __forceinline__ void a_ready(const Unit&) const {}
    __device__ __forceinline__ void done(const Unit&) const {}
};

typedef float f32x2_cv __attribute__((ext_vector_type(2))); typedef __bf16 bf16x2_cv __attribute__((ext_vector_type(2)));
__device__ __forceinline__ unsigned cvt_pk_bf16(float lo, float hi) { f32x2_cv v = {lo, hi}; bf16x2_cv b = __builtin_convertvector(v, bf16x2_cv); return __builtin_bit_cast(unsigned, b); }
__device__ __forceinline__ float bf_lo(unsigned u) { return __uint_as_float(u << 16); }
__device__ __forceinline__ float bf_hi(unsigned u) { return __uint_as_float(u & 0xffff0000u); }
struct EpiUni {
    static constexpr bool PERM = true, AFTER_DRAIN = false;
    int mode; bf16_t* O; int ldc; const bf16_t* gates; int ldg; const float* cw; const float* cb; PG8_LAS unsigned char* hlds;
    __device__ __forceinline__ bool keep(const Unit& u) const { return mode == 3 && (u.pm >> 6) < 2; }
    __device__ __forceinline__ void operator()(f32x4 (&acc)[2][2][4][2], const Unit& u, int wr, int wc, int fr, int fq) const {
        int ln_; asm volatile("v_mbcnt_lo_u32_b32 %0, -1, 0\n\tv_mbcnt_hi_u32_b32 %0, -1, %0" : "=v"(ln_)); (void)fr; (void)fq;
        int mode_ = mode; int pm_ = u.pm, pn_ = u.pn; const bf16_t* gp = gates;
        if (mode == 3) { const int b = u.pm >> 6; pm_ = u.pm & 63; pn_ = u.pn & 3; gp = gates + 1024 * b; mode_ = b < 2 ? 6 : 7; }
        const int row0 = pm_ * BM + wr * 64 + (ln_ & 15); const int col0 = pn_ * BM + wc * 32 + 8 * (ln_ >> 4);
        if (mode_ == 6 || mode_ == 7) {
#pragma unroll
            for (int ai = 0; ai < 2; ++ai)
#pragma unroll
                for (int m = 0; m < 4; ++m) { const size_t row = (size_t)(row0 + ai * HALF + m * 16);
#pragma unroll
                    for (int bj = 0; bj < 2; ++bj) { const int col = col0 + bj * HALF;
                        const u32x4 g = *(const u32x4*)(gp + row * ldg + col);
                        const float ga[8] = {bf_lo(g.x), bf_hi(g.x), bf_lo(g.y), bf_hi(g.y), bf_lo(g.z), bf_hi(g.z), bf_lo(g.w), bf_hi(g.w)};
                        float f[8];
#pragma unroll
                        for (int e = 0; e < 8; ++e) f[e] = __builtin_amdgcn_rcpf(1.0f + __expf(-fminf(fmaxf(ga[e], -30.f), 30.f)));
                        if (mode_ == 6) { const u32x4 h = *(const u32x4*)(gp + 1024 + row * ldg + col);
                            const float gb[8] = {bf_lo(h.x), bf_hi(h.x), bf_lo(h.y), bf_hi(h.y), bf_lo(h.z), bf_hi(h.z), bf_lo(h.w), bf_hi(h.w)};
#pragma unroll
                            for (int e = 0; e < 8; ++e) f[e] *= 1.0f + __expf(-fminf(fmaxf(gb[e], -30.f), 30.f)); }
                        f32x4 v0 = acc[ai][bj][m][0], v1 = acc[ai][bj][m][1];
                        v0[0] *= f[0]; v0[1] *= f[1]; v0[2] *= f[2]; v0[3] *= f[3]; v1[0] *= f[4]; v1[1] *= f[5]; v1[2] *= f[6]; v1[3] *= f[7];
                        acc[ai][bj][m][0] = v0; acc[ai][bj][m][1] = v1;
                        if (mode_ == 7) { u32x4 w; w.x = cvt_pk_bf16(v0[0], v0[1]); w.y = cvt_pk_bf16(v0[2], v0[3]); w.z = cvt_pk_bf16(v1[0], v1[1]); w.w = cvt_pk_bf16(v1[2], v1[3]);
                            *(u32x4*)(O + row * ldc + col) = w; } } }
        } else
        if (mode_ == 5) {
            const int frl = ln_ & 15, fql = ln_ >> 4;
            PG8_LAS float* Hs = (PG8_LAS float*)hlds;
            if (frl >= 14) {
#pragma unroll
                for (int ai = 0; ai < 2; ++ai)
#pragma unroll
                    for (int bj = 0; bj < 2; ++bj)
#pragma unroll
                        for (int n = 0; n < 2; ++n) *(PG8_LAS f32x4*)(Hs + (((ai * 2 + wr) * 2 + (frl - 14)) * 256 + bj * 128 + wc * 32 + 8 * fql + 4 * n)) = acc[ai][bj][3][n]; }
            asm volatile("s_waitcnt lgkmcnt(0)" ::: "memory"); __builtin_amdgcn_s_barrier(); asm volatile("" ::: "memory");
            const int gcol = 128 * pn_ + wc * 32 + 8 * fql, NU2 = 2 * ldc;
#pragma unroll
            for (int n = 0; n < 2; ++n) {
                f32x4 wgk[3], wvk[3];
#pragma unroll
                for (int k = 0; k < 3; ++k) { wgk[k] = *(const f32x4*)(cw + k * NU2 + gcol + 4 * n); wvk[k] = *(const f32x4*)(cw + k * NU2 + ldc + gcol + 4 * n); }
                const f32x4 bgk = *(const f32x4*)(cb + gcol + 4 * n), bvk = *(const f32x4*)(cb + ldc + gcol + 4 * n);
#pragma unroll
                for (int ai = 0; ai < 2; ++ai)
#pragma unroll
                    for (int m = 0; m < 4; ++m) { const int r = ai * HALF + wr * 64 + m * 16 + frl; const int t = 254 * pm_ + r - 2;
                        f32x4 X[2], P1[2], P2[2];
#pragma unroll
                        for (int bj = 0; bj < 2; ++bj) { X[bj] = acc[ai][bj][m][n];
                            f32x4 Xp;
                            if (m > 0) Xp = acc[ai][bj][m > 0 ? m - 1 : 0][n];
                            else { const int pb = ai * 2 + wr - 1 >= 0 ? ai * 2 + wr - 1 : 0; Xp = *(const PG8_LAS f32x4*)(Hs + (pb * 2 + (frl & 1)) * 256 + bj * 128 + wc * 32 + 8 * fql + 4 * n); }
#pragma unroll
                            for (int e2 = 0; e2 < 4; ++e2) { const float s1 = frl == 15 ? Xp[e2] : X[bj][e2], s2 = frl >= 14 ? Xp[e2] : X[bj][e2];
                                P1[bj][e2] = __int_as_float(__builtin_amdgcn_mov_dpp(__float_as_int(s1), 0x121, 0xF, 0xF, false));
                                P2[bj][e2] = __int_as_float(__builtin_amdgcn_mov_dpp(__float_as_int(s2), 0x122, 0xF, 0xF, false)); } }
                        const f32x4 cg = bgk + wgk[0] * P2[0] + wgk[1] * P1[0] + wgk[2] * X[0]; const f32x4 cv = bvk + wvk[0] * P2[1] + wvk[1] * P1[1] + wvk[2] * X[1];
                        const f32x4 y = (cg + (cg * cg) * cg * 0.044715f) * (-2.3022082f);
                        f32x4 o;
#pragma unroll
                        for (int e2 = 0; e2 < 4; ++e2) o[e2] = cg[e2] * __builtin_amdgcn_rcpf(1.0f + __builtin_amdgcn_exp2f(y[e2])) * cv[e2];
                        if (r >= 2 && t < ldg) { typedef unsigned u32x2v __attribute__((ext_vector_type(2))); u32x2v w; w.x = cvt_pk_bf16(o[0], o[1]); w.y = cvt_pk_bf16(o[2], o[3]); *(u32x2v*)(O + (size_t)t * ldc + gcol + 4 * n) = w; } }
            }
        } else
        if (mode_ == 0) {
#pragma unroll
            for (int ai = 0; ai < 2; ++ai)
#pragma unroll
                for (int m = 0; m < 4; ++m) { bf16_t* rowp = O + (size_t)(row0 + ai * HALF + m * 16) * ldc + col0;
#pragma unroll
                    for (int bj = 0; bj < 2; ++bj) { const f32x4 v0 = acc[ai][bj][m][0], v1 = acc[ai][bj][m][1];
                        u32x4 w; w.x = cvt_pk_bf16(v0[0], v0[1]); w.y = cvt_pk_bf16(v0[2], v0[3]); w.z = cvt_pk_bf16(v1[0], v1[1]); w.w = cvt_pk_bf16(v1[2], v1[3]);
                        *(u32x4*)(rowp + bj * HALF) = w; } }
        }
    }
};
template <class Epi, class Sched, bool ALIGN_EPI = false, bool SP2 = false>
__device__ __forceinline__ void gemm_phase(PG8_LAS unsigned char* lds, const Gemm g, const Sched& S, const Epi& E, const int tid) {
    const int wid = __builtin_amdgcn_readfirstlane(tid >> 6), lane = tid & 63, wr = wid >> 2, wc = wid & 3, fr = lane & 15, fq = lane >> 4;
    const int K = g.K, nt = K / BK;
    unsigned voffA[2], voffB[2];
#pragma unroll
    for (int i = 0; i < 2; ++i) { int R, C; stage_rc(tid * 16 + i * 8192, R, C); const int Rb = Epi::PERM ? ((R & ~31) + perm32(R & 31)) : R;
        voffA[i] = (unsigned)(R * K + C) * 2u; voffB[i] = (unsigned)(Rb * K + C) * 2u; }
    const size_t kstep = (size_t)(BK * 2);
    const size_t hstep = (size_t)HALF * K * 2;
    const size_t tstep = 2 * hstep;
    const size_t tstepA = (size_t)g.a_rows * K * 2;
    const unsigned ldsw = (unsigned)wid * 1024u;
    const int aoff = lds_byte(wr * 64 + fr, fq * 8), boff = lds_byte(wc * 32 + fr, fq * 8);
#define PG8_SA(b, h) (((b) * 2 + (h)) * HTB)
#define PG8_SB(b, h) ((4 + (b) * 2 + (h)) * HTB)
#define PG8_STAGE(bufoff, gbase, voff) do { _Pragma("unroll") for (int _i = 0; _i < 2; ++_i) \
        __builtin_amdgcn_global_load_lds((const unsigned*)((const char*)(gbase) + (voff)[_i]), (PG8_LAS unsigned*)(lds + (bufoff) + ldsw + _i * 8192), 16, 0, 0); } while (0)
#define PG8_LDA(dst, b, h) do { _Pragma("unroll") for (int m = 0; m < 4; ++m) _Pragma("unroll") for (int k = 0; k < 2; ++k) dst[m][k] = *(const PG8_LAS bf16x8*)(lds + PG8_SA(b, h) + aoff + m * 2048 + k * 1024); } while (0)
#define PG8_LDB(dst, b, h) do { _Pragma("unroll") for (int n = 0; n < 2; ++n) _Pragma("unroll") for (int k = 0; k < 2; ++k) dst[n][k] = *(const PG8_LAS bf16x8*)(lds + PG8_SB(b, h) + boff + n * 2048 + k * 1024); } while (0)
#define PG8_MMA(ai, bj, At, Bt) do { __builtin_amdgcn_s_setprio(1); _Pragma("unroll") for (int m = 0; m < 4; ++m) _Pragma("unroll") for (int n = 0; n < 2; ++n) _Pragma("unroll") for (int k = 0; k < 2; ++k) \
        acc[ai][bj][m][n] = __builtin_amdgcn_mfma_f32_16x16x32_bf16(Bt[n][k], At[m][k], acc[ai][bj][m][n], 0, 0, 0); __builtin_amdgcn_s_setprio(0); } while (0)
#define PG8_WAIT_V(n) asm volatile("s_waitcnt vmcnt(" #n ")" ::: "memory")
#define PG8_WAIT_L(n) asm volatile("s_waitcnt lgkmcnt(" #n ")" ::: "memory")
#define PG8_BAR __builtin_amdgcn_s_barrier()
#define PG8_SCHED __builtin_amdgcn_sched_barrier(0)
    Unit cur, nxt; int ui = 0;
    if (!S.next(0, cur)) return;
    f32x4 acc[2][2][4][2];
#pragma unroll
    for (int a = 0; a < 2; ++a)
#pragma unroll
        for (int b = 0; b < 2; ++b)
#pragma unroll
            for (int m = 0; m < 4; ++m)
#pragma unroll
                for (int n = 0; n < 2; ++n) acc[a][b][m][n] = (f32x4){0.f, 0.f, 0.f, 0.f};
    bf16x8 At[4][2], B0[2][2], B1[2][2];
    const char* cA = (const char*)g.A + (size_t)cur.pm * tstepA; const char* cB = (const char*)g.Bt + (size_t)cur.pn * tstep;
    S.a_ready(cur);
    if constexpr (SP2) {
        PG8_STAGE(PG8_SB(0, 0), cB, voffB); PG8_STAGE(PG8_SB(0, 1), cB + hstep, voffB); PG8_STAGE(PG8_SA(0, 0), cA, voffA); PG8_STAGE(PG8_SA(0, 1), cA + hstep, voffA);
        if (wr == 1) PG8_BAR;
        PG8_WAIT_V(2); PG8_BAR;
        PG8_STAGE(PG8_SB(1, 0), cB + kstep, voffB); PG8_STAGE(PG8_SA(1, 0), cA + kstep, voffA); PG8_STAGE(PG8_SB(1, 1), cB + hstep + kstep, voffB);
        PG8_WAIT_V(6); PG8_BAR;
    } else {
        PG8_STAGE(PG8_SB(0, 0), cB, voffB); PG8_STAGE(PG8_SA(0, 0), cA, voffA); PG8_STAGE(PG8_SB(0, 1), cB + hstep, voffB); PG8_STAGE(PG8_SA(0, 1), cA + hstep, voffA);
        if (wr == 1) PG8_BAR;
        PG8_WAIT_V(4); PG8_BAR;
        PG8_STAGE(PG8_SB(1, 0), cB + kstep, voffB); PG8_STAGE(PG8_SA(1, 0), cA + kstep, voffA); PG8_STAGE(PG8_SB(1, 1), cB + hstep + kstep, voffB);
        PG8_WAIT_V(6); PG8_BAR;
    }
    for (;;) {
        const bool has_next = S.next(ui + 1, nxt);
        const char* nA = has_next ? (const char*)g.A + (size_t)nxt.pm * tstepA : cA; const char* nB = has_next ? (const char*)g.Bt + (size_t)nxt.pn * tstep : cB;
        for (int t = 0; t < nt; t += 2) {
            const bool last = (t == nt - 2);
            const char* a1 = cA + (size_t)(t + 1) * kstep;
            const char* a2 = last ? nA : cA + (size_t)(t + 2) * kstep; const char* b2 = last ? nB : cB + (size_t)(t + 2) * kstep;
            const char* a3 = a2 + kstep; const char* b3 = b2 + kstep;
            if (last && has_next) S.a_ready(nxt);
            if constexpr (SP2) {
            PG8_LDB(B0, 0, 0); PG8_LDB(B1, 0, 1); PG8_SCHED; PG8_LDA(At, 0, 0); PG8_STAGE(PG8_SA(1, 1), a1 + hstep, voffA);
            PG8_WAIT_V(8); PG8_WAIT_L(0); PG8_BAR; PG8_MMA(0, 0, At, B0); PG8_MMA(0, 1, At, B1); PG8_BAR; PG8_SCHED;
            PG8_LDA(At, 0, 1); PG8_STAGE(PG8_SB(0, 0), b2, voffB); PG8_STAGE(PG8_SB(0, 1), b2 + hstep, voffB); PG8_STAGE(PG8_SA(0, 0), a2, voffA);
            PG8_WAIT_V(8); PG8_WAIT_L(0); PG8_BAR; PG8_MMA(1, 0, At, B0); PG8_MMA(1, 1, At, B1); PG8_BAR; PG8_SCHED;
            PG8_LDB(B0, 1, 0); PG8_LDB(B1, 1, 1); PG8_SCHED; PG8_LDA(At, 1, 0); PG8_STAGE(PG8_SA(0, 1), a2 + hstep, voffA);
            PG8_WAIT_V(8); PG8_WAIT_L(0); PG8_BAR; PG8_MMA(0, 0, At, B0); PG8_MMA(0, 1, At, B1); PG8_BAR; PG8_SCHED;
            PG8_LDA(At, 1, 1); PG8_STAGE(PG8_SB(1, 0), b3, voffB); PG8_STAGE(PG8_SB(1, 1), b3 + hstep, voffB); PG8_STAGE(PG8_SA(1, 0), a3, voffA);
            PG8_WAIT_V(8); PG8_WAIT_L(0); PG8_BAR; PG8_MMA(1, 0, At, B0); PG8_MMA(1, 1, At, B1); PG8_BAR; PG8_SCHED;
            } else {
            PG8_LDB(B0, 0, 0); PG8_SCHED; PG8_LDA(At, 0, 0); PG8_STAGE(PG8_SA(1, 1), a1 + hstep, voffA);
            PG8_WAIT_L(8); PG8_BAR; PG8_WAIT_L(0); PG8_MMA(0, 0, At, B0); PG8_BAR; PG8_SCHED;
            PG8_LDB(B1, 0, 1); PG8_STAGE(PG8_SB(0, 0), b2, voffB);
            PG8_BAR; PG8_WAIT_L(0); PG8_MMA(0, 1, At, B1); PG8_BAR;
            PG8_LDA(At, 0, 1); PG8_STAGE(PG8_SA(0, 0), a2, voffA);
            PG8_BAR; PG8_WAIT_L(0); PG8_MMA(1, 0, At, B0); PG8_BAR; PG8_SCHED;
            PG8_STAGE(PG8_SB(0, 1), b2 + hstep, voffB);
            PG8_WAIT_V(6); PG8_BAR; PG8_MMA(1, 1, At, B1); PG8_BAR;
            PG8_LDB(B0, 1, 0); PG8_SCHED; PG8_LDA(At, 1, 0); PG8_STAGE(PG8_SA(0, 1), a2 + hstep, voffA);
            PG8_WAIT_L(8); PG8_BAR; PG8_WAIT_L(0); PG8_MMA(0, 0, At, B0); PG8_BAR; PG8_SCHED;
            PG8_LDB(B1, 1, 1); PG8_STAGE(PG8_SB(1, 0), b3, voffB);
            PG8_BAR; PG8_WAIT_L(0); PG8_MMA(0, 1, At, B1); PG8_BAR;
            PG8_LDA(At, 1, 1); PG8_STAGE(PG8_SA(1, 0), a3, voffA);
            PG8_BAR; PG8_WAIT_L(0); PG8_MMA(1, 0, At, B0); PG8_BAR; PG8_SCHED;
            PG8_STAGE(PG8_SB(1, 1), b3 + hstep, voffB);
            PG8_WAIT_V(6); PG8_BAR; PG8_MMA(1, 1, At, B1); PG8_BAR;
            }
        }
        if constexpr (ALIGN_EPI) { if (wr == 0) PG8_BAR; }
        if constexpr (!Epi::AFTER_DRAIN) { E(acc, cur, wr, wc, fr, fq); S.done(cur); }
        if (!has_next) break;
        if (!E.keep(cur)) {
#pragma unroll
        for (int a = 0; a < 2; ++a)
#pragma unroll
            for (int b = 0; b < 2; ++b)
#pragma unroll
                for (int m = 0; m < 4; ++m)
#pragma unroll
                    for (int n = 0; n < 2; ++n) acc[a][b][m][n] = (f32x4){0.f, 0.f, 0.f, 0.f};
        }
        cur = nxt; cA = nA; cB = nB; ++ui;
        if constexpr (ALIGN_EPI) { if (wr == 1) PG8_BAR; }
    }
    PG8_WAIT_V(0);
    if constexpr (!ALIGN_EPI) { if (wr == 0) PG8_BAR; }
    PG8_BAR;
    if constexpr (Epi::AFTER_DRAIN) { E.fused(acc, cur, wr, wc, fr, fq, lds, wid, lane); S.done(cur); }
#undef PG8_SA
#undef PG8_SB
#undef PG8_STAGE
#undef PG8_LDA
#undef PG8_LDB
#undef PG8_MMA
#undef PG8_WAIT_V
#undef PG8_WAIT_L
#undef PG8_BAR
#undef PG8_SCHED
}
}
constexpr int T = 16384, D = 1024, NSRC = 5904, NIN = 6144, FF = 2816, NUP = 5632, DEPTH = 4;
constexpr int PQ = 0, PK = 256, PV = 512, PLG = 1024, PR = 1280, SQ = 1792, SK = 2304, SV = 2432, PU = 2560, PG = 3072;
constexpr float EPS = 1e-6f;
constexpr size_t MiB = 1u << 20;
constexpr size_t WS_WIN = 0, WS_WUP = 12 * MiB, WS_WDN = 23 * MiB, WS_WB = 29 * MiB  , WS_WOUT = 32 * MiB;
constexpr size_t WS_B2 = 34 * MiB;
constexpr size_t WS_H = WS_B2, WS_YG = WS_B2 + 32 * MiB, WS_YS = WS_B2 + 48 * MiB, WS_YP = WS_B2 + 64 * MiB, WS_UT = WS_B2 + 80 * MiB, WS_SB = WS_B2 + 112 * MiB, WS_AD = WS_B2 + 128 * MiB;
constexpr size_t WS_ACT = WS_B2 + 33 * MiB;
constexpr size_t WS_B1 = 164 * MiB;
constexpr size_t WS_CTL = WS_B1 + 192 * MiB;
constexpr size_t WS_END = WS_CTL + 1 * MiB;
constexpr int LDS_BYTES = 147456;

#define GAS __attribute__((address_space(1)))
#define LAS __attribute__((address_space(3)))
typedef unsigned short bf16;
typedef unsigned v4u __attribute__((ext_vector_type(4)));
typedef unsigned v2u __attribute__((ext_vector_type(2)));
typedef float f32x4 __attribute__((ext_vector_type(4)));
typedef short bf16x8 __attribute__((ext_vector_type(8)));
typedef short s16x4 __attribute__((ext_vector_type(4)));
#define LDS_WAIT() asm volatile("s_waitcnt lgkmcnt(0)" ::: "memory")

__device__ __forceinline__ unsigned pk2(float lo, float hi) { return pg8::cvt_pk_bf16(lo, hi); }
__device__ __forceinline__ float bflo(unsigned u) { return __uint_as_float(u << 16); }
__device__ __forceinline__ float bfhi(unsigned u) { return __uint_as_float(u & 0xffff0000u); }
__device__ __forceinline__ void unpack8(const v4u v, float* f) { f[0] = bflo(v.x); f[1] = bfhi(v.x); f[2] = bflo(v.y); f[3] = bfhi(v.y); f[4] = bflo(v.z); f[5] = bfhi(v.z); f[6] = bflo(v.w); f[7] = bfhi(v.w); }
__device__ __forceinline__ v4u pack8(const float* f) { v4u o; o.x = pk2(f[0], f[1]); o.y = pk2(f[2], f[3]); o.z = pk2(f[4], f[5]); o.w = pk2(f[6], f[7]); return o; }
__device__ __forceinline__ float shfl_idx(float v, int src) { return __int_as_float(__builtin_amdgcn_ds_bpermute(src << 2, __float_as_int(v))); }
__device__ __forceinline__ float wave_sum(float v, int lane) {
#pragma unroll
    for (int o = 1; o < 64; o <<= 1) v += shfl_idx(v, lane ^ o);
    return v;
}
__device__ __forceinline__ float lsig(float x) { return fminf(x, 0.f) - __logf(1.0f + __expf(-fabsf(x))); }
__device__ __forceinline__ f32x4 mfma16(bf16x8 a, bf16x8 b, f32x4 c) { return __builtin_amdgcn_mfma_f32_16x16x32_bf16(a, b, c, 0, 0, 0); }

struct Args { const float* in[20]; float* out; unsigned char* ws; };

struct TrDesc { const float* W; bf16* Wt; int N, K, k0, s0, d0; float scale; };
__device__ __forceinline__ void tr_load(const TrDesc& t, f32x4 (&v)[16], int lane) {
    const int kr = lane >> 4, c4 = (lane & 15) * 4;
#pragma unroll
    for (int i = 0; i < 16; ++i) v[i] = *(const f32x4*)(t.W + (size_t)(t.k0 + 4 * i + kr) * t.N + t.s0 + c4);
}
__device__ __forceinline__ void tr_finish(const TrDesc& t, const f32x4 (&v)[16], LAS float* scr, int lane) {
    const int kr = lane >> 4, c4 = (lane & 15) * 4;
#pragma unroll
    for (int i = 0; i < 16; ++i) { LAS float* d = scr + (4 * i + kr) * 65 + c4; d[0] = v[i][0] * t.scale; d[1] = v[i][1] * t.scale; d[2] = v[i][2] * t.scale; d[3] = v[i][3] * t.scale; }
    LDS_WAIT();
    const int c = lane & 7;
#pragma unroll
    for (int j = 0; j < 8; ++j) { const int n = (lane >> 3) + 8 * j; const LAS float* s = scr + (8 * c) * 65 + n;
        v4u o; o.x = pk2(s[0 * 65], s[1 * 65]); o.y = pk2(s[2 * 65], s[3 * 65]); o.z = pk2(s[4 * 65], s[5 * 65]); o.w = pk2(s[6 * 65], s[7 * 65]);
        *(v4u*)(t.Wt + (size_t)(t.d0 + n) * t.K + t.k0 + 8 * c) = o; }
    LDS_WAIT();
}
__device__ __forceinline__ void prep_weights(const Args& a, int l, LAS unsigned char* lds, int G, int bid, int tid) {
    const int wave = tid >> 6, lane = tid & 63;
    LAS float* scr = (LAS float*)(lds + wave * 16640);
    const int gw = bid * 8 + wave, NGW = G * 8;
    unsigned char* ws = a.ws;
    const float* w_in = a.in[5] + (size_t)l * D * NSRC;
    const float* w_up = a.in[16] + (size_t)l * D * NUP;
    const float* w_dn = a.in[19] + (size_t)l * FF * D;
    const float* w_bg = a.in[12] + (size_t)l * 512 * D;
    const float* w_bs = a.in[13] + (size_t)l * 512 * D;
    const float* w_bp = a.in[14] + (size_t)l * 512 * D;
    const float* w_out = a.in[15] + (size_t)l * D * D;
    bf16* Win_t = (bf16*)(ws + WS_WIN); bf16* Wup_t = (bf16*)(ws + WS_WUP); bf16* Wdn_t = (bf16*)(ws + WS_WDN); bf16* Wb_t = (bf16*)(ws + WS_WB); bf16* Wout_t = (bf16*)(ws + WS_WOUT);
    auto decode = [&](int it) -> TrDesc { TrDesc t; int r = it;
        if (r < 1472) { const int nb = r >> 4, kb = r & 15; const int d0 = 64 * (nb < 16 ? nb : nb + 4);
            t = TrDesc{w_in, Win_t, NSRC, D, 64 * kb, d0 < 1024 ? d0 : d0 - 240, d0, (d0 < 256 || (d0 >= SQ && d0 < SK)) ? 0.125f : 1.0f}; return t; }
        r -= 1472;
        if (r < 1408) { const int nb = r >> 4, kb = r & 15; const int j = nb >> 2, q = nb & 3;
            t = TrDesc{w_up, Wup_t, NUP, D, 64 * kb, q < 2 ? 128 * j + 64 * q : FF + 128 * j + 64 * (q - 2), 64 * nb, 1.0f}; return t; }
        r -= 1408;
        if (r < 704) { const int nb = r / 44, kb = r % 44; t = TrDesc{w_dn, Wdn_t, D, FF, 64 * kb, 64 * nb, 64 * nb, 1.0f}; return t; }
        r -= 704;
        if (r < 128) { const int nb = r >> 3, kb = r & 7; t = TrDesc{w_bg, Wb_t, D, 512, 64 * kb, 64 * nb, 64 * nb, 1.0f}; return t; }
        r -= 128;
        if (r < 128) { const int nb = r >> 3, kb = r & 7; t = TrDesc{w_bs, Wb_t + 1024 * 512, D, 512, 64 * kb, 64 * nb, 64 * nb, 1.0f}; return t; }
        r -= 128;
        { const int nb = r >> 4, kb = r & 15; t = TrDesc{w_out, Wout_t, D, D, 64 * kb, 64 * nb, 64 * nb, 1.0f}; return t; } };
    for (int it = gw; it < 4096; it += 2 * NGW) {
        const bool two = it + NGW < 4096;
        const TrDesc t0 = decode(it), t1 = decode(two ? it + NGW : it);
        f32x4 v0[16], v1[16];
        tr_load(t0, v0, lane); if (two) tr_load(t1, v1, lane);
        tr_finish(t0, v0, scr, lane); if (two) tr_finish(t1, v1, scr, lane);
    }
    const int gt = bid * 512 + tid, GT = G * 512;
    { const float* wgu = a.in[6] + (size_t)l * 16 * 256;
      for (int q = gt; q < 256 * 128; q += GT) { const int n = q & 255, kc = q >> 8;
          float wg[16];
#pragma unroll
          for (int r = 0; r < 16; ++r) wg[r] = wgu[r * 256 + n];
          float o[8];
#pragma unroll
          for (int e = 0; e < 8; ++e) { const f32x4* src = (const f32x4*)(w_in + (size_t)(8 * kc + e) * NSRC + 1024); float s = 0.f;
#pragma unroll
              for (int r4 = 0; r4 < 4; ++r4) { const f32x4 v = src[r4]; s += v[0] * wg[4 * r4] + v[1] * wg[4 * r4 + 1] + v[2] * wg[4 * r4 + 2] + v[3] * wg[4 * r4 + 3]; }
              o[e] = s; }
          *(v4u*)(Win_t + (size_t)(PLG + n) * D + 8 * kc) = pack8(o); } }
    { const float* pw = a.in[10] + (size_t)l * 4 * 128 * 128; const float* psc = a.in[11] + (size_t)l * 512; bf16* Wp_t = Wb_t + 2 * 1024 * 512;
      for (int q = gt; q < 1024 * 128; q += GT) { const int n = q & 1023, cc = __builtin_amdgcn_readfirstlane(q >> 10); const int g = cc >> 5, c0 = (cc & 31) * 4;
          const float* pwr = pw + ((size_t)g * 128 + c0) * 128; const float* wb = w_bp + (size_t)(128 * g) * D + n; const float* sc = psc + 128 * g;
#pragma unroll
          for (int r = 0; r < 4; ++r) { scr[r * 128 + lane] = pwr[r * 128 + lane]; scr[r * 128 + 64 + lane] = pwr[r * 128 + 64 + lane]; }
          scr[512 + lane] = sc[lane]; scr[512 + 64 + lane] = sc[64 + lane];
          LDS_WAIT();
          float o0 = 0.f, o1 = 0.f, o2 = 0.f, o3 = 0.f;
#pragma unroll 8
          for (int d = 0; d < 128; d += 4) { const f32x4 s4 = *(const LAS f32x4*)(scr + 512 + d);
              const f32x4 p0 = *(const LAS f32x4*)(scr + d), p1 = *(const LAS f32x4*)(scr + 128 + d), p2 = *(const LAS f32x4*)(scr + 256 + d), p3 = *(const LAS f32x4*)(scr + 384 + d);
              const float w0 = s4[0] * wb[(size_t)(d + 0) * D], w1 = s4[1] * wb[(size_t)(d + 1) * D], w2 = s4[2] * wb[(size_t)(d + 2) * D], w3 = s4[3] * wb[(size_t)(d + 3) * D];
              o0 += p0[0] * w0 + p0[1] * w1 + p0[2] * w2 + p0[3] * w3; o1 += p1[0] * w0 + p1[1] * w1 + p1[2] * w2 + p1[3] * w3;
              o2 += p2[0] * w0 + p2[1] * w1 + p2[2] * w2 + p2[3] * w3; o3 += p3[0] * w0 + p3[1] * w1 + p3[2] * w2 + p3[3] * w3; }
          LDS_WAIT();
          v2u w; w.x = pk2(o0, o1); w.y = pk2(o2, o3); *(v2u*)(Wp_t + (size_t)n * 512 + 128 * g + c0) = w; } }
}

__device__ __forceinline__ void rows_norm_first(const float* __restrict__ x, const float* __restrict__ g, bf16* __restrict__ h, int gw, int NGW, int lane) {
    f32x4 gv[4];
#pragma unroll
    for (int j = 0; j < 4; ++j) gv[j] = ((const f32x4*)g)[lane + 64 * j];
    for (int m = gw; m < T; m += NGW) {
        const f32x4* xr = (const f32x4*)(x + (size_t)m * D) + lane; f32x4 v[4]; float s = 0.f;
#pragma unroll
        for (int j = 0; j < 4; ++j) { v[j] = xr[64 * j]; s += (v[j].x * v[j].x + v[j].y * v[j].y) + (v[j].z * v[j].z + v[j].w * v[j].w); }
        const float rs = rsqrtf(wave_sum(s, lane) * (1.f / D) + EPS);
        v2u* o = (v2u*)(h + (size_t)m * D) + lane;
#pragma unroll
        for (int j = 0; j < 4; ++j) { v2u w; w.x = pk2(v[j].x * rs * gv[j].x, v[j].y * rs * gv[j].y); w.y = pk2(v[j].z * rs * gv[j].z, v[j].w * rs * gv[j].w); o[64 * j] = w; }
    }
}
__device__ __forceinline__ void rows_residual(const bf16* __restrict__ ob, const float* xin, float* xout, const float* __restrict__ gpost, const float* __restrict__ gnext, bf16* __restrict__ h, bf16* hzero, int gw, int NGW, int lane) {
    f32x4 gp[4], gn[4];
#pragma unroll
    for (int j = 0; j < 4; ++j) { gp[j] = ((const f32x4*)gpost)[lane + 64 * j]; gn[j] = gnext ? ((const f32x4*)gnext)[lane + 64 * j] : (f32x4){0.f, 0.f, 0.f, 0.f}; }
    if (hzero && gw == 0) { unsigned zz = 0u; asm volatile("" : "+v"(zz)); v4u z; z.x = zz; z.y = zz; z.z = zz; z.w = zz;
#pragma unroll
        for (int j = 0; j < 4; ++j) ((v4u*)hzero)[lane + 64 * j] = z; }
    for (int m0 = gw; m0 < T; m0 += 2 * NGW) {
        f32x4 ov[2][4], xv[2][4]; float s[2] = {0.f, 0.f};
#pragma unroll
        for (int rr = 0; rr < 2; ++rr) { const int m = m0 + rr * NGW; const v2u* orow = (const v2u*)(ob + (size_t)m * D) + lane; const f32x4* xr = (const f32x4*)(xin + (size_t)m * D) + lane;
#pragma unroll
            for (int j = 0; j < 4; ++j) { const v2u w = orow[64 * j]; xv[rr][j] = xr[64 * j]; ov[rr][j] = (f32x4){bflo(w.x), bfhi(w.x), bflo(w.y), bfhi(w.y)}; } }
#pragma unroll
        for (int rr = 0; rr < 2; ++rr)
#pragma unroll
            for (int j = 0; j < 4; ++j) s[rr] += (ov[rr][j].x * ov[rr][j].x + ov[rr][j].y * ov[rr][j].y) + (ov[rr][j].z * ov[rr][j].z + ov[rr][j].w * ov[rr][j].w);
#pragma unroll
        for (int o = 1; o < 64; o <<= 1) { const float t0 = shfl_idx(s[0], lane ^ o), t1 = shfl_idx(s[1], lane ^ o); s[0] += t0; s[1] += t1; }
        float s2[2] = {0.f, 0.f};
#pragma unroll
        for (int rr = 0; rr < 2; ++rr) { const int m = m0 + rr * NGW; const float rs = rsqrtf(s[rr] * (1.f / D) + EPS); f32x4* xo = (f32x4*)(xout + (size_t)m * D) + lane;
#pragma unroll
            for (int j = 0; j < 4; ++j) { xv[rr][j] = xv[rr][j] + ov[rr][j] * rs * gp[j]; xo[64 * j] = xv[rr][j];
                s2[rr] += (xv[rr][j].x * xv[rr][j].x + xv[rr][j].y * xv[rr][j].y) + (xv[rr][j].z * xv[rr][j].z + xv[rr][j].w * xv[rr][j].w); } }
        if (gnext) {
#pragma unroll
            for (int o = 1; o < 64; o <<= 1) { const float t0 = shfl_idx(s2[0], lane ^ o), t1 = shfl_idx(s2[1], lane ^ o); s2[0] += t0; s2[1] += t1; }
#pragma unroll
            for (int rr = 0; rr < 2; ++rr) { const int m = m0 + rr * NGW; const float r2 = rsqrtf(s2[rr] * (1.f / D) + EPS); v2u* o = (v2u*)(h + (size_t)m * D) + lane;
#pragma unroll
                for (int j = 0; j < 4; ++j) { v2u w; w.x = pk2(xv[rr][j].x * r2 * gn[j].x, xv[rr][j].y * r2 * gn[j].y); w.y = pk2(xv[rr][j].z * r2 * gn[j].z, xv[rr][j].w * r2 * gn[j].w); o[64 * j] = w; } } }
    }
}
__device__ __forceinline__ void swa_phase(LAS unsigned char* lds, const bf16* __restrict__ proj, const float* __restrict__ sinks, bf16* __restrict__ ys, int G, int bid, int tid) {
    LAS bf16* Ks = (LAS bf16*)lds; LAS bf16* VT = (LAS bf16*)(lds + 36864);
    const int wave = tid >> 6, lane = tid & 63, fr = lane & 15, fq = lane >> 4;
    for (int u = bid; u < 256; u += G) {
        const int nb = u >> 1, kh = u & 1;
#pragma unroll
        for (int i = 0; i < 4; ++i) { const int p = tid + 512 * i; const int row = p >> 3, ch = p & 7; int t = 128 * nb - 128 + row; if (t < 0) t += 128;
            const v4u kv = *(const v4u*)(proj + (size_t)t * NIN + SK + 64 * kh + 8 * ch); *(LAS v4u*)(Ks + row * 72 + 8 * ch) = kv; }
#pragma unroll
        for (int i = 0; i < 4; ++i) { const int p = tid + 512 * i; const int key = p & 255, ch = p >> 8; int t = 128 * nb - 128 + key; if (t < 0) t += 128;
            const v4u vv = *(const v4u*)(proj + (size_t)t * NIN + SV + 64 * kh + 8 * ch);
            LAS bf16* vp = VT + (8 * ch) * 264 + key;
            vp[0 * 264] = (bf16)(vv.x & 0xffffu); vp[1 * 264] = (bf16)(vv.x >> 16); vp[2 * 264] = (bf16)(vv.y & 0xffffu); vp[3 * 264] = (bf16)(vv.y >> 16);
            vp[4 * 264] = (bf16)(vv.z & 0xffffu); vp[5 * 264] = (bf16)(vv.z >> 16); vp[6 * 264] = (bf16)(vv.w & 0xffffu); vp[7 * 264] = (bf16)(vv.w >> 16); }
        __syncthreads();
        const int rb = __builtin_amdgcn_readfirstlane(wave); const size_t trow = (size_t)(128 * nb + 16 * rb + fr);
        bf16x8 q0 = *(const bf16x8*)(proj + trow * NIN + SQ + 64 * (4 * kh) + 8 * fq), q1 = *(const bf16x8*)(proj + trow * NIN + SQ + 64 * (4 * kh) + 32 + 8 * fq);
#pragma unroll 1
        for (int g = 0; g < 4; ++g) {
            const int hq = 4 * kh + g; const int hn = 4 * kh + (g < 3 ? g + 1 : 3);
            const bf16x8 qn0 = *(const bf16x8*)(proj + trow * NIN + SQ + 64 * hn + 8 * fq), qn1 = *(const bf16x8*)(proj + trow * NIN + SQ + 64 * hn + 32 + 8 * fq);
            f32x4 s[9];
#pragma unroll
            for (int j = 0; j < 9; ++j) { const LAS bf16* kp = Ks + (16 * (rb + j) + fr) * 72 + 8 * fq;
                const bf16x8 k0 = *(const LAS bf16x8*)kp, k1 = *(const LAS bf16x8*)(kp + 32);
                s[j] = mfma16(k0, q0, (f32x4){0.f, 0.f, 0.f, 0.f}); s[j] = mfma16(k1, q1, s[j]); }
            const int dd = 4 * fq - fr; const int jmin = nb > 0 ? 0 : 8 - rb;
            float mx = -1e30f;
#pragma unroll
            for (int j = 0; j < 9; ++j)
#pragma unroll
                for (int r = 0; r < 4; ++r) { bool ok = j >= jmin; if (j == 0) ok = ok && (dd + r >= 1); if (j == 8) ok = ok && (dd + r <= 0);
                    s[j][r] = ok ? s[j][r] : -1e30f; mx = fmaxf(mx, s[j][r]); }
            mx = fmaxf(mx, shfl_idx(mx, lane ^ 16)); mx = fmaxf(mx, shfl_idx(mx, lane ^ 32));
            const float sk = sinks[hq]; mx = fmaxf(mx, sk);
            float sum = 0.f;
#pragma unroll
            for (int j = 0; j < 9; ++j)
#pragma unroll
                for (int r = 0; r < 4; ++r) { const float p = s[j][r] > -1e29f ? __expf(s[j][r] - mx) : 0.f; s[j][r] = p; sum += p; }
            sum += shfl_idx(sum, lane ^ 16); sum += shfl_idx(sum, lane ^ 32);
            const float inv = 1.0f / (sum + __expf(sk - mx));
            bf16x8 pf[5];
#pragma unroll
            for (int jj = 0; jj < 5; ++jj) { const f32x4 a = s[2 * jj] * inv; const f32x4 b = jj < 4 ? s[2 * jj + 1] * inv : (f32x4){0.f, 0.f, 0.f, 0.f};
                v4u w; w.x = pk2(a[0], a[1]); w.y = pk2(a[2], a[3]); w.z = pk2(b[0], b[1]); w.w = pk2(b[2], b[3]); pf[jj] = __builtin_bit_cast(bf16x8, w); }
#pragma unroll
            for (int nt = 0; nt < 4; ++nt) { f32x4 o = {0.f, 0.f, 0.f, 0.f}; const LAS bf16* vp = VT + (16 * nt + fr) * 264 + 16 * rb + 4 * fq;
#pragma unroll
                for (int jj = 0; jj < 5; ++jj) { const int j0 = 2 * jj, j1 = jj < 4 ? 2 * jj + 1 : 8;
                    const v2u lo = *(const LAS v2u*)(vp + 16 * j0), hi = *(const LAS v2u*)(vp + 16 * j1);
                    v4u av; av.x = lo.x; av.y = lo.y; av.z = hi.x; av.w = hi.y;
                    o = mfma16(__builtin_bit_cast(bf16x8, av), pf[jj], o); }
                v2u w; w.x = pk2(o[0], o[1]); w.y = pk2(o[2], o[3]);
                *(v2u*)(ys + trow * 512 + 64 * hq + 16 * nt + 4 * fq) = w; }
            q0 = qn0; q1 = qn1;
        }
        __syncthreads();
    }
}

__device__ __forceinline__ void pool_phase(const bf16* __restrict__ proj, bf16* __restrict__ dp, int gw, int NGW, int lane) {
    const int w = 2 << (lane >> 4);
    const bf16* up = proj + PU + 8 * lane;
    for (int task = gw; task < 2048; task += NGW) {
        const int t0 = task * 8;
        float s[8] = {0.f, 0.f, 0.f, 0.f, 0.f, 0.f, 0.f, 0.f};
#pragma unroll
        for (int k = 1; k < 16; ++k) { if (k < w && t0 - k >= 0) { float f[8]; unpack8(*(const v4u*)(up + (size_t)(t0 - k) * NIN), f);
#pragma unroll
                for (int e = 0; e < 8; ++e) s[e] += f[e]; } }
#pragma unroll
        for (int r = 0; r < 8; ++r) { const int t = t0 + r; float f[8]; unpack8(*(const v4u*)(up + (size_t)t * NIN), f);
            const float ic = 1.0f / (float)(t + 1 < w ? t + 1 : w); float o[8];
#pragma unroll
            for (int e = 0; e < 8; ++e) { s[e] += f[e]; o[e] = s[e] * ic - f[e]; }
            *(v4u*)(dp + (size_t)t * 512 + 8 * lane) = pack8(o);
            const int tl = t - w + 1;
            if (tl >= 0) { float g[8]; unpack8(*(const v4u*)(up + (size_t)tl * NIN), g);
#pragma unroll
                for (int e = 0; e < 8; ++e) s[e] -= g[e]; } }
    }
}

__device__ __forceinline__ void lane_scan8(float* v, int lane) {
#pragma unroll
    for (int off = 1; off < 64; off <<= 1) {
#pragma unroll
        for (int e = 0; e < 8; ++e) { const float t = shfl_idx(v[e], lane - off); v[e] += (lane >= off) ? t : 0.f; } }
}
__device__ __forceinline__ void glaa_phase(LAS unsigned char* lds, const bf16* __restrict__ proj, const float* __restrict__ bgate, float* __restrict__ UT, float* __restrict__ AD, int G, int bid, int tid) {
    const int qd = tid >> 7, hw = (tid >> 6) & 1, lane = tid & 63, fr = lane & 15, fq = lane >> 4;
    LAS bf16* KT = (LAS bf16*)(lds + qd * 27648); LAS bf16* VT = KT + 64 * 72;
    for (int it = bid; it < 256; it += G) {
        const int u = 4 * it + qd; const int h = u & 3;
        const bf16* rowp = proj + (size_t)(64 * (u >> 2) + lane) * NIN;
#pragma unroll
        for (int ii = 0; ii < 4; ++ii) { const int db = hw * 4 + ii;
            float b[8]; { float f[8]; unpack8(*(const v4u*)(rowp + PLG + 64 * h + 8 * db), f);
#pragma unroll
                for (int e = 0; e < 8; ++e) b[e] = lsig(f[e] + bgate[64 * h + 8 * db + e]) * 0.0625f; }
            lane_scan8(b, lane);
            float kf[8]; unpack8(*(const v4u*)(rowp + PK + 64 * h + 8 * db), kf);
#pragma unroll
            for (int e = 0; e < 8; ++e) { const float bl = __int_as_float(__builtin_amdgcn_readlane(__float_as_int(b[e]), 63)); const float kt = kf[e] * __expf(bl - b[e]);
                KT[(8 * db + e) * 72 + lane] = (bf16)(pk2(kt, 0.f) & 0xffffu);
                if (lane == 63) AD[(size_t)u * 64 + 8 * db + e] = __expf(bl); } }
#pragma unroll
        for (int i = 0; i < 8; ++i) { const int ch = hw * 8 + i; const v4u vv = *(const v4u*)(rowp + PV + 128 * h + 8 * ch);
            LAS bf16* vp = VT + (8 * ch) * 72 + lane;
            vp[0 * 72] = (bf16)(vv.x & 0xffffu); vp[1 * 72] = (bf16)(vv.x >> 16); vp[2 * 72] = (bf16)(vv.y & 0xffffu); vp[3 * 72] = (bf16)(vv.y >> 16);
            vp[4 * 72] = (bf16)(vv.z & 0xffffu); vp[5 * 72] = (bf16)(vv.z >> 16); vp[6 * 72] = (bf16)(vv.w & 0xffffu); vp[7 * 72] = (bf16)(vv.w >> 16); }
        __syncthreads();
#pragma unroll
        for (int nn = 0; nn < 4; ++nn) { const int nt = 4 * hw + nn;
            const LAS bf16* bp = VT + (16 * nt + fr) * 72 + 8 * fq; const bf16x8 b0 = *(const LAS bf16x8*)bp, b1 = *(const LAS bf16x8*)(bp + 32);
#pragma unroll
            for (int mt = 0; mt < 4; ++mt) { const LAS bf16* ap = KT + (16 * mt + fr) * 72 + 8 * fq; const bf16x8 a0 = *(const LAS bf16x8*)ap, a1 = *(const LAS bf16x8*)(ap + 32);
                f32x4 acc = mfma16(a0, b0, (f32x4){0.f, 0.f, 0.f, 0.f}); acc = mfma16(a1, b1, acc);
                *(f32x4*)(UT + ((size_t)u * 128 + 16 * nt + fr) * 64 + 16 * mt + 4 * fq) = acc; } }
        __syncthreads();
    }
}
__device__ __forceinline__ void gla_scan_phase(LAS unsigned char* lds, const float* __restrict__ UT, const float* __restrict__ AD, bf16* __restrict__ SB, int G, int bid, int tid) {
    LAS f32x4* SL = (LAS f32x4*)lds;
    const int egl = tid & 31, seg = tid >> 5;
    for (int blk = bid; blk < 256; blk += G) {
        const int e0 = (blk * 32 + egl) * 4; const int ai0 = (e0 >> 13) * 64 + (e0 & 63);
        const float* up = UT + (size_t)(seg * 16) * 32768 + e0; const float* ap = AD + (seg * 16) * 256 + ai0;
        f32x4 uu[16], aa[16];
#pragma unroll
        for (int i = 0; i < 16; ++i) { uu[i] = *(const f32x4*)(up + (size_t)i * 32768); aa[i] = *(const f32x4*)(ap + i * 256); }
        f32x4 S = {0.f, 0.f, 0.f, 0.f}, Pp = {1.f, 1.f, 1.f, 1.f};
#pragma unroll
        for (int i = 0; i < 16; ++i) { S = aa[i] * S + uu[i]; Pp = Pp * aa[i]; }
        SL[seg * 32 + egl] = S; SL[512 + seg * 32 + egl] = Pp;
        __syncthreads();
        f32x4 C = {0.f, 0.f, 0.f, 0.f};
#pragma unroll 1
        for (int s = 0; s < seg; ++s) C = SL[512 + s * 32 + egl] * C + SL[s * 32 + egl];
        S = C;
        bf16* sp = SB + (size_t)(seg * 16) * 32768 + e0;
#pragma unroll
        for (int i = 0; i < 16; ++i) { v2u w; w.x = pk2(S[0], S[1]); w.y = pk2(S[2], S[3]); *(v2u*)(sp + (size_t)i * 32768) = w; S = aa[i] * S + uu[i]; }
        __syncthreads();
    }
}
__device__ __forceinline__ void glac_phase(LAS unsigned char* lds, const bf16* __restrict__ proj, const bf16* __restrict__ SB, const float* __restrict__ bgate, const float* __restrict__ gnorm, bf16* __restrict__ yg, int G, int bid, int tid) {
    const int half = tid >> 8, hw = (tid >> 6) & 3, lane = tid & 63, fr = lane & 15, fq = lane >> 4;
    LAS bf16* Qs = (LAS bf16*)(lds + half * 36864); LAS bf16* Ks = Qs + 64 * 72; LAS bf16* VT = Ks + 64 * 72;
    for (int it = bid; it < 512; it += G) {
        const int u = 2 * it + half; const int c = u >> 2, h = u & 3;
        const bf16* rowp = proj + (size_t)(64 * c + lane) * NIN;
#pragma unroll
        for (int ii = 0; ii < 2; ++ii) { const int db = hw * 2 + ii;
            float b[8]; { float f[8]; unpack8(*(const v4u*)(rowp + PLG + 64 * h + 8 * db), f);
#pragma unroll
                for (int e = 0; e < 8; ++e) b[e] = lsig(f[e] + bgate[64 * h + 8 * db + e]) * 0.0625f; }
            lane_scan8(b, lane);
            float qf[8], kf[8]; unpack8(*(const v4u*)(rowp + PQ + 64 * h + 8 * db), qf); unpack8(*(const v4u*)(rowp + PK + 64 * h + 8 * db), kf);
#pragma unroll
            for (int e = 0; e < 8; ++e) { const float eb = __expf(b[e]); qf[e] *= eb; kf[e] *= __builtin_amdgcn_rcpf(eb); }
            *(LAS v4u*)(Qs + lane * 72 + 8 * db) = pack8(qf); *(LAS v4u*)(Ks + lane * 72 + 8 * db) = pack8(kf); }
#pragma unroll
        for (int i = 0; i < 4; ++i) { const int ch = hw * 4 + i; const v4u vv = *(const v4u*)(rowp + PV + 128 * h + 8 * ch);
            LAS bf16* vp = VT + (8 * ch) * 72 + lane;
            vp[0 * 72] = (bf16)(vv.x & 0xffffu); vp[1 * 72] = (bf16)(vv.x >> 16); vp[2 * 72] = (bf16)(vv.y & 0xffffu); vp[3 * 72] = (bf16)(vv.y >> 16);
            vp[4 * 72] = (bf16)(vv.z & 0xffffu); vp[5 * 72] = (bf16)(vv.z >> 16); vp[6 * 72] = (bf16)(vv.w & 0xffffu); vp[7 * 72] = (bf16)(vv.w >> 16); }
        __syncthreads();
        const LAS bf16* qp = Qs + (16 * hw + fr) * 72 + 8 * fq; const bf16x8 q0 = *(const LAS bf16x8*)qp, q1 = *(const LAS bf16x8*)(qp + 32);
        f32x4 s[4];
#pragma unroll
        for (int jt = 0; jt < 4; ++jt) { const LAS bf16* kp = Ks + (16 * jt + fr) * 72 + 8 * fq; const bf16x8 k0 = *(const LAS bf16x8*)kp, k1 = *(const LAS bf16x8*)(kp + 32);
            s[jt] = mfma16(k0, q0, (f32x4){0.f, 0.f, 0.f, 0.f}); s[jt] = mfma16(k1, q1, s[jt]);
#pragma unroll
            for (int r = 0; r < 4; ++r) s[jt][r] = (16 * jt + 4 * fq + r <= 16 * hw + fr) ? s[jt][r] : 0.f; }
        bf16x8 pf[2];
#pragma unroll
        for (int jj = 0; jj < 2; ++jj) { v4u w; w.x = pk2(s[2 * jj][0], s[2 * jj][1]); w.y = pk2(s[2 * jj][2], s[2 * jj][3]); w.z = pk2(s[2 * jj + 1][0], s[2 * jj + 1][1]); w.w = pk2(s[2 * jj + 1][2], s[2 * jj + 1][3]); pf[jj] = __builtin_bit_cast(bf16x8, w); }
        f32x4 o[8]; float ss = 0.f;
#pragma unroll
        for (int nt = 0; nt < 8; ++nt) { const LAS bf16* vp = VT + (16 * nt + fr) * 72 + 4 * fq;
            const v2u a0 = *(const LAS v2u*)vp, a1 = *(const LAS v2u*)(vp + 16), a2 = *(const LAS v2u*)(vp + 32), a3 = *(const LAS v2u*)(vp + 48);
            v4u A0; A0.x = a0.x; A0.y = a0.y; A0.z = a1.x; A0.w = a1.y; v4u A1; A1.x = a2.x; A1.y = a2.y; A1.z = a3.x; A1.w = a3.y;
            const bf16* sp = SB + ((size_t)u * 128 + 16 * nt + fr) * 64 + 8 * fq; const bf16x8 S0 = *(const bf16x8*)sp, S1 = *(const bf16x8*)(sp + 32);
            f32x4 acc = mfma16(__builtin_bit_cast(bf16x8, A0), pf[0], (f32x4){0.f, 0.f, 0.f, 0.f}); acc = mfma16(__builtin_bit_cast(bf16x8, A1), pf[1], acc);
            acc = mfma16(S0, q0, acc); acc = mfma16(S1, q1, acc); o[nt] = acc;
            ss += (acc[0] * acc[0] + acc[1] * acc[1]) + (acc[2] * acc[2] + acc[3] * acc[3]); }
        ss += shfl_idx(ss, lane ^ 16); ss += shfl_idx(ss, lane ^ 32);
        const float rinv = rsqrtf(ss * (1.0f / 128.0f) + EPS);
        const size_t trow = (size_t)(64 * c + 16 * hw + fr);
#pragma unroll
        for (int nt = 0; nt < 8; ++nt) { const int n = 128 * h + 16 * nt + 4 * fq; const f32x4 gn = *(const f32x4*)(gnorm + n);
            const v2u rv = *(const v2u*)(proj + trow * NIN + PR + n); const float rr[4] = {bflo(rv.x), bfhi(rv.x), bflo(rv.y), bfhi(rv.y)}; float ov[4];
#pragma unroll
            for (int e = 0; e < 4; ++e) ov[e] = o[nt][e] * rinv * gn[e] * rr[e] * __builtin_amdgcn_rcpf(1.0f + __expf(-rr[e]));
            v2u w; w.x = pk2(ov[0], ov[1]); w.y = pk2(ov[2], ov[3]); *(v2u*)(yg + trow * 512 + n) = w; }
        __syncthreads();
    }
}
struct Ptrs { bf16 *Win_t, *Wup_t, *Wdn_t, *Wb_t, *Wout_t, *hbuf, *yg, *ysw, *yp, *SB, *act, *proj; float *UT, *AD; };
__device__ __forceinline__ Ptrs mkptrs(unsigned char* ws) { Ptrs P;
    P.Win_t = (bf16*)(ws + WS_WIN); P.Wup_t = (bf16*)(ws + WS_WUP); P.Wdn_t = (bf16*)(ws + WS_WDN); P.Wb_t = (bf16*)(ws + WS_WB); P.Wout_t = (bf16*)(ws + WS_WOUT);
    P.hbuf = (bf16*)(ws + WS_H); P.yg = (bf16*)(ws + WS_YG); P.ysw = (bf16*)(ws + WS_YS); P.yp = (bf16*)(ws + WS_YP); P.UT = (float*)(ws + WS_UT); P.SB = (bf16*)(ws + WS_SB); P.AD = (float*)(ws + WS_AD);
    P.act = (bf16*)(ws + WS_ACT); P.proj = (bf16*)(ws + WS_B1); return P; }
__device__ __forceinline__ void load_args(Args& a, const __attribute__((address_space(4))) Args* p) {
#pragma unroll
    for (int i = 0; i < 20; ++i) a.in[i] = p->in[i];
    a.out = p->out; a.ws = p->ws; }
#define XB_TMO      128
#define XB_XCNT(j)  (256  + 64 * (j))
#define XB_XSUB(j)  (1280 + 64 * (j))
#define XB_XGEN(j)  (2304 + 64 * (j))
#define XB_TOP      3328
#define XB_TOPGEN   3392
#define XCD_BAR_WORDS 3456
#define XB_SPIN_CAP (1u << 18)

__device__ __forceinline__ unsigned xb_ld(unsigned* p)              { return __hip_atomic_load(p, __ATOMIC_RELAXED, __HIP_MEMORY_SCOPE_AGENT); }
__device__ __forceinline__ unsigned xb_add(unsigned* p, unsigned v) { return __hip_atomic_fetch_add(p, v, __ATOMIC_RELAXED, __HIP_MEMORY_SCOPE_AGENT); }
__device__ __forceinline__ unsigned xb_xcc_id() { return (unsigned)__builtin_amdgcn_s_getreg((3 << 11) | 20) & 0xFu; }
#define XB_SPIN(cond, bar) do { unsigned _sp = 0; while (cond) { __builtin_amdgcn_s_sleep(1); \
    if ((++_sp & 255u) == 0u) { if (xb_ld(&(bar)[XB_TMO])) break; if (_sp > XB_SPIN_CAP) { atomicAdd(&(bar)[XB_TMO], 1u); break; } } } } while (0)
__device__ __forceinline__ void grid_bar(unsigned* bar, volatile LAS unsigned* st, unsigned G, int wave, int lane) {
    asm volatile("s_waitcnt vmcnt(0)" ::: "memory");
    __syncthreads();
    if (wave == 0 && lane == 0) {
        const unsigned x = xb_xcc_id();
        __builtin_amdgcn_s_waitcnt(0);
        unsigned nloc = st[0], nx = st[1];
        if (nloc == 0u) {
            unsigned sum, cnt, mine, sp = 0u;
            for (;;) { sum = 0u; cnt = 0u; mine = 0u;
#pragma unroll
                for (unsigned j = 0; j < 16; ++j) { const unsigned c = xb_ld(&bar[XB_XCNT(j)]); sum += c; cnt += (c > 0u) ? 1u : 0u; mine = (j == x) ? c : mine; }
                if (sum == G) break;
                __builtin_amdgcn_s_sleep(1);
                if ((++sp & 255u) == 0u) { if (xb_ld(&bar[XB_TMO])) break; if (sp > XB_SPIN_CAP) { atomicAdd(&bar[XB_TMO], 1u); break; } } }
            nloc = mine > 0u ? mine : 1u; nx = cnt > 0u ? cnt : 1u; st[0] = nloc; st[1] = nx; }
        const unsigned old = xb_add(&bar[XB_XSUB(x)], 1u);
        const unsigned gen = old / nloc;
        if (old + 1u == (gen + 1u) * nloc) {
            __builtin_amdgcn_fence(__ATOMIC_RELEASE, "agent");
            asm volatile("s_waitcnt vmcnt(0)" ::: "memory");
            const unsigned og = xb_add(&bar[XB_TOP], 1u);
            const unsigned tg = og / nx;
            if (og + 1u == (tg + 1u) * nx) xb_add(&bar[XB_TOPGEN], 1u);
            else XB_SPIN(xb_ld(&bar[XB_TOPGEN]) == tg, bar);
            __builtin_amdgcn_fence(__ATOMIC_ACQUIRE, "agent");
            xb_add(&bar[XB_XGEN(x)], 1u);
            asm volatile("s_waitcnt vmcnt(0)" ::: "memory");
        } else {
            XB_SPIN(xb_ld(&bar[XB_XGEN(x)]) == gen, bar);
            __builtin_amdgcn_fence(__ATOMIC_ACQUIRE, "agent");
            asm volatile("s_waitcnt vmcnt(0)" ::: "memory");
        }
    }
    __syncthreads();
}
#define PHASE_VARS() int bid = bid0; asm volatile("" : "+s"(bid)); int G = G0; asm volatile("" : "+s"(G)); int wv_ = wave0; asm volatile("" : "+s"(wv_)); const int wave = wv_; \
    int ln_; asm volatile("v_mbcnt_lo_u32_b32 %0, -1, 0\n\tv_mbcnt_hi_u32_b32 %0, -1, %0" : "=v"(ln_)); const int lane = ln_; const int tid = wave * 64 + lane; \
    const __attribute__((address_space(4))) Args* ap_ = (const __attribute__((address_space(4))) Args*)__builtin_amdgcn_kernarg_segment_ptr(); asm volatile("" : "+s"(ap_)); \
    Args a; load_args(a, ap_); float* xout = a.out; (void)xout; const Ptrs P = mkptrs(a.ws); \
    const int gw = bid * 8 + wave, NGW = G * 8, gt = bid * 512 + tid, GT = G * 512; (void)gw; (void)NGW; (void)gt; (void)GT
__global__ void __launch_bounds__(512, 2) mk_fwd(Args a_unused) {
    extern __shared__ __attribute__((aligned(16))) unsigned char lds_raw[];
    LAS unsigned char* lds = (LAS unsigned char*)lds_raw;
    const int G0 = gridDim.x, bid0 = blockIdx.x;
    const int wave0 = __builtin_amdgcn_readfirstlane(threadIdx.x >> 6);
    if (blockIdx.x == 0) for (int i = threadIdx.x; i < XCD_BAR_WORDS; i += 512) __hip_atomic_store((unsigned*)(a_unused.ws + WS_CTL) + i, 0u, __ATOMIC_RELAXED, __HIP_MEMORY_SCOPE_AGENT);
    if (threadIdx.x < 2) ((LAS unsigned*)(lds + LDS_BYTES - 16))[threadIdx.x] = 0u;
    cg::this_grid().sync();
    if (threadIdx.x == 0) (void)xb_add((unsigned*)(a_unused.ws + WS_CTL) + XB_XCNT(xb_xcc_id()), 1u);
#define GRID_SYNC() do { PHASE_VARS(); grid_bar((unsigned*)(a.ws + WS_CTL), (volatile LAS unsigned*)(lds + LDS_BYTES - 16), (unsigned)G, wave, lane); } while (0)
#pragma unroll 1
    for (int l = -1; l < DEPTH; ++l) {
#pragma unroll 1
        for (int step = l < 0 ? 12 : 0; step < 13; ++step) {
            if (step == 5 || step == 6 || step == 10) continue;
            if ((0x0A91 >> step) & 1) {
              { PHASE_VARS();
                const bf16* A = P.hbuf; const bf16* Bt = P.Win_t; int N = NIN, K = D; pg8::EpiUni E{0, P.proj, NIN, nullptr, NIN, nullptr, nullptr, lds + 131072};
                int tri = 0, a_rows = 256, Mr = T;
                if (step == 4) { A = P.yg; Bt = P.Wb_t; N = D; K = 512; tri = 1; E = pg8::EpiUni{3, P.hbuf, D, P.proj + PG, NIN, nullptr, nullptr, lds + 131072}; }
                else if (step == 7) { A = P.hbuf; Bt = P.Wout_t; N = D; K = D; E = pg8::EpiUni{0, P.proj, D, nullptr, NIN, nullptr, nullptr, lds + 131072}; }
                else if (step == 9) { A = P.hbuf; Bt = P.Wup_t; N = NUP; K = D; a_rows = 254; Mr = 65 * 256; E = pg8::EpiUni{5, P.act, FF, nullptr, T, a.in[17] + (size_t)l * 3 * NUP, a.in[18] + (size_t)l * NUP, lds + 131072}; }
                else if (step == 11) { A = P.act; Bt = P.Wdn_t; N = D; K = FF; E = pg8::EpiUni{0, P.proj, D, nullptr, NIN, nullptr, nullptr, lds + 131072}; }
                pg8::Gemm g{A, Bt, Mr, N, K, a_rows}; pg8::StaticOrder S; S.init(Mr, N, G, bid); S.tri = tri;
                pg8::gemm_phase<pg8::EpiUni, pg8::StaticOrder, true, true>(lds, g, S, E, tid); }
            } else if (step == 1) {
                { PHASE_VARS(); swa_phase(lds, P.proj, a.in[9] + l * 8, P.ysw, G, bid, tid); }
                { PHASE_VARS(); pool_phase(P.proj, P.yp, gw, NGW, lane); }
                { PHASE_VARS(); glaa_phase(lds, P.proj, a.in[7] + l * 256, P.UT, P.AD, G, bid, tid); }
            } else if (step == 2) { PHASE_VARS(); gla_scan_phase(lds, P.UT, P.AD, P.SB, G, bid, tid);
            } else if (step == 3) { PHASE_VARS(); glac_phase(lds, P.proj, P.SB, a.in[7] + l * 256, a.in[8] + l * 512, P.yg, G, bid, tid);
            } else {
#pragma unroll 1
                for (int pass = 0; pass < 2; ++pass) {
                    PHASE_VARS();
                    const bool do_prep = (pass == 0) != ((wave & 1) != 0);
                    if (do_prep) { if (step == 12 && l + 1 < DEPTH) prep_weights(a, l + 1, lds, G, bid, tid); }
                    else if (l < 0) rows_norm_first(a.in[0], a.in[1], P.hbuf, gw, NGW, lane);
                    else { const bool r1 = step == 8;
                        const float* xin = (r1 && l == 0) ? a.in[0] : xout; const float* gpost = (r1 ? a.in[2] : a.in[4]) + l * D;
                        const float* gnext = r1 ? a.in[3] + l * D : (l + 1 < DEPTH ? a.in[1] + (l + 1) * D : nullptr);
                        rows_residual(P.proj, xin, xout, gpost, gnext, r1 ? P.hbuf + 2 * D : P.hbuf, r1 ? P.hbuf : nullptr, gw, NGW, lane); }
                }
            }
            if (!(l + 1 == DEPTH && step == 12)) GRID_SYNC();
        }
    }
}

extern "C" void kernel_launch(void* const* d_in, const int* in_sizes, int n_in, void* d_out, int out_size, void* d_ws, size_t ws_size, hipStream_t stream) {
    static int grid = 0;
    if (grid == 0) {
        if (n_in != 20 || out_size != T * D || ws_size < WS_END) { fprintf(stderr, "kernel_launch: unexpected shapes (n_in %d out %d ws %zu, need %zu)\n", n_in, out_size, ws_size, (size_t)WS_END); grid = -1; return; }
        int dev = 0, cus = 0, per_cu = 0;
        (void)hipGetDevice(&dev); (void)hipDeviceGetAttribute(&cus, hipDeviceAttributeMultiprocessorCount, dev);
        (void)hipFuncSetAttribute((const void*)mk_fwd, hipFuncAttributeMaxDynamicSharedMemorySize, LDS_BYTES);
        if (hipOccupancyMaxActiveBlocksPerMultiprocessor(&per_cu, (const void*)mk_fwd, 512, LDS_BYTES) != hipSuccess || per_cu < 1) per_cu = 1;
        (void)hipGetLastError();
        grid = cus * per_cu;
        fprintf(stderr, "kernel_launch: grid %d (cus %d x %d), ws %zu\n", grid, cus, per_cu, ws_size);
    }
    if (grid < 0) return;
    Args a{};
    for (int i = 0; i < 20; ++i) a.in[i] = (const float*)d_in[i];
    a.out = (float*)d_out; a.ws = (unsigned char*)d_ws;
    void* args[] = {&a};
    hipError_t e = hipLaunchCooperativeKernel((void*)mk_fwd, dim3(grid), dim3(512), args, LDS_BYTES, stream);
    if (e != hipSuccess) fprintf(stderr, "cooperative launch failed: %s (grid %d)\n", hipGetErrorString(e), grid);
}
```

```cpp
#include <hip/hip_runtime.h>
#include <hip/hip_cooperative_groups.h>
#include <cstdio>
#include <cstdint>
namespace cg = cooperative_groups;
namespace pg8 {
#define PG8_LAS __attribute__((address_space(3)))
typedef unsigned short bf16_t;
typedef short bf16x8 __attribute__((ext_vector_type(8)));
typedef float f32x4 __attribute__((ext_vector_type(4)));
typedef unsigned u32x4 __attribute__((ext_vector_type(4)));
constexpr int BM = 256, BK = 64, HALF = 128, HTB = HALF * BK * 2  , STAGE_BYTES = 8 * HTB, NXCD = 8, WGM = 8;

__host__ __device__ __forceinline__ int lds_byte(int r, int c) { const int st = (r >> 4) * 2 + (c >> 5), rr = r & 15, cc = c & 31, ob = rr * 64 + cc * 2; return st * 1024 + (ob ^ (((ob >> 9) & 1) << 5)); }
__host__ __device__ __forceinline__ void stage_rc(int b, int& R, int& C) { const int st = b / 1024, sb = b % 1024, swz = sb ^ (((sb >> 9) & 1) << 5); R = (st >> 1) * 16 + swz / 64; C = (st & 1) * 32 + (swz % 64) / 2; }
__host__ __device__ __forceinline__ int perm32(int rho) { const int n = rho >> 4, i = rho & 15; return 8 * (i >> 2) + 4 * n + (i & 3); }

struct Unit { int pm, pn; };
struct Gemm { const bf16_t* A; const bf16_t* Bt; int M, N, K; int a_rows; };

struct StaticOrder {
    int nM, nN, nwg, G, c;
    __host__ __device__ void init(int M, int N, int G_, int c_) { nM = M / BM; nN = N / BM; nwg = nM * nN; G = G_; c = c_; tri = 0; }
    int tri;
    __host__ __device__ bool next(int i_, Unit& u) const {
        const int i = tri ? 0 : i_; if (tri && i_ >= 3) return false;
        const long L = (long)i * G + c; if (L >= nwg) return false;
        int wgid = (int)L; { const int q = nwg / NXCD, r = nwg % NXCD, xcd = wgid % NXCD, off = wgid / NXCD; wgid = (xcd < r ? xcd * (q + 1) : r * (q + 1) + (xcd - r) * q) + off; }
        const int nig = WGM * nN, gid = wgid / nig, fm = gid * WGM, gsz = (nM - fm) < WGM ? (nM - fm) : WGM;
        u.pm = fm + ((wgid % nig) % gsz); u.pn = (wgid % nig) / gsz; if (tri) { u.pm += 64 * i_; u.pn += 4 * i_; } return true;
    }
    __device__ __forceinline__ void a_ready(const Unit&) const {}
    __device__ __forceinline__ void done(const Unit&) const {}
};

typedef float f32x2_cv __attribute__((ext_vector_type(2))); typedef __bf16 bf16x2_cv __attribute__((ext_vector_type(2)));
__device__ __forceinline__ unsigned cvt_pk_bf16(float lo, float hi) { f32x2_cv v = {lo, hi}; bf16x2_cv b = __builtin_convertvector(v, bf16x2_cv); return __builtin_bit_cast(unsigned, b); }
__device__ __forceinline__ float bf_lo(unsigned u) { return __uint_as_float(u << 16); }
__device__ __forceinline__ float bf_hi(unsigned u) { return __uint_as_float(u & 0xffff0000u); }
struct EpiUni {
    static constexpr bool PERM = true, AFTER_DRAIN = false;
    int mode; bf16_t* O; int ldc; const bf16_t* gates; int ldg; const float* cw; const float* cb; PG8_LAS unsigned char* hlds;
    __device__ __forceinline__ bool keep(const Unit& u) const { return mode == 3 && (u.pm >> 6) < 2; }
    __device__ __forceinline__ void operator()(f32x4 (&acc)[2][2][4][2], const Unit& u, int wr, int wc, int fr, int fq) const {
        int ln_; asm volatile("v_mbcnt_lo_u32_b32 %0, -1, 0\n\tv_mbcnt_hi_u32_b32 %0, -1, %0" : "=v"(ln_)); (void)fr; (void)fq;
        int mode_ = mode; int pm_ = u.pm, pn_ = u.pn; const bf16_t* gp = gates;
        if (mode == 3) { const int b = u.pm >> 6; pm_ = u.pm & 63; pn_ = u.pn & 3; gp = gates + 1024 * b; mode_ = b < 2 ? 6 : 7; }
        const int row0 = pm_ * BM + wr * 64 + (ln_ & 15); const int col0 = pn_ * BM + wc * 32 + 8 * (ln_ >> 4);
        if (mode_ == 6 || mode_ == 7) {
#pragma unroll
            for (int ai = 0; ai < 2; ++ai)
#pragma unroll
                for (int m = 0; m < 4; ++m) { const size_t row = (size_t)(row0 + ai * HALF + m * 16);
#pragma unroll
                    for (int bj = 0; bj < 2; ++bj) { const int col = col0 + bj * HALF;
                        const u32x4 g = *(const u32x4*)(gp + row * ldg + col);
                        const float ga[8] = {bf_lo(g.x), bf_hi(g.x), bf_lo(g.y), bf_hi(g.y), bf_lo(g.z), bf_hi(g.z), bf_lo(g.w), bf_hi(g.w)};
                        float f[8];
#pragma unroll
                        for (int e = 0; e < 8; ++e) f[e] = __builtin_amdgcn_rcpf(1.0f + __expf(-fminf(fmaxf(ga[e], -30.f), 30.f)));
                        if (mode_ == 6) { const u32x4 h = *(const u32x4*)(gp + 1024 + row * ldg + col);
                            const float gb[8] = {bf_lo(h.x), bf_hi(h.x), bf_lo(h.y), bf_hi(h.y), bf_lo(h.z), bf_hi(h.z), bf_lo(h.w), bf_hi(h.w)};
#pragma unroll
                            for (int e = 0; e < 8; ++e) f[e] *= 1.0f + __expf(-fminf(fmaxf(gb[e], -30.f), 30.f)); }
                        f32x4 v0 = acc[ai][bj][m][0], v1 = acc[ai][bj][m][1];
                        v0[0] *= f[0]; v0[1] *= f[1]; v0[2] *= f[2]; v0[3] *= f[3]; v1[0] *= f[4]; v1[1] *= f[5]; v1[2] *= f[6]; v1[3] *= f[7];
                        acc[ai][bj][m][0] = v0; acc[ai][bj][m][1] = v1;
                        if (mode_ == 7) { u32x4 w; w.x = cvt_pk_bf16(v0[0], v0[1]); w.y = cvt_pk_bf16(v0[2], v0[3]); w.z = cvt_pk_bf16(v1[0], v1[1]); w.w = cvt_pk_bf16(v1[2], v1[3]);
                            *(u32x4*)(O + row * ldc + col) = w; } } }
        } else
        if (mode_ == 5) {
            const int frl = ln_ & 15, fql = ln_ >> 4;
            PG8_LAS float* Hs = (PG8_LAS float*)hlds;
            if (frl >= 14) {
#pragma unroll
                for (int ai = 0; ai < 2; ++ai)
#pragma unroll
                    for (int bj = 0; bj < 2; ++bj)
#pragma unroll
                        for (int n = 0; n < 2; ++n) *(PG8_LAS f32x4*)(Hs + (((ai * 2 + wr) * 2 + (frl - 14)) * 256 + bj * 128 + wc * 32 + 8 * fql + 4 * n)) = acc[ai][bj][3][n]; }
            asm volatile("s_waitcnt lgkmcnt(0)" ::: "memory"); __builtin_amdgcn_s_barrier(); asm volatile("" ::: "memory");
            const int gcol = 128 * pn_ + wc * 32 + 8 * fql, NU2 = 2 * ldc;
#pragma unroll
            for (int n = 0; n < 2; ++n) {
                f32x4 wgk[3], wvk[3];
#pragma unroll
                for (int k = 0; k < 3; ++k) { wgk[k] = *(const f32x4*)(cw + k * NU2 + gcol + 4 * n); wvk[k] = *(const f32x4*)(cw + k * NU2 + ldc + gcol + 4 * n); }
                const f32x4 bgk = *(const f32x4*)(cb + gcol + 4 * n), bvk = *(const f32x4*)(cb + ldc + gcol + 4 * n);
#pragma unroll
                for (int ai = 0; ai < 2; ++ai)
#pragma unroll
                    for (int m = 0; m < 4; ++m) { const int r = ai * HALF + wr * 64 + m * 16 + frl; const int t = 254 * pm_ + r - 2;
                        f32x4 X[2], P1[2], P2[2];
#pragma unroll
                        for (int bj = 0; bj < 2; ++bj) { X[bj] = acc[ai][bj][m][n];
                            f32x4 Xp;
                            if (m > 0) Xp = acc[ai][bj][m > 0 ? m - 1 : 0][n];
                            else { const int pb = ai * 2 + wr - 1 >= 0 ? ai * 2 + wr - 1 : 0; Xp = *(const PG8_LAS f32x4*)(Hs + (pb * 2 + (frl & 1)) * 256 + bj * 128 + wc * 32 + 8 * fql + 4 * n); }
#pragma unroll
                            for (int e2 = 0; e2 < 4; ++e2) { const float s1 = frl == 15 ? Xp[e2] : X[bj][e2], s2 = frl >= 14 ? Xp[e2] : X[bj][e2];
                                P1[bj][e2] = __int_as_float(__builtin_amdgcn_mov_dpp(__float_as_int(s1), 0x121, 0xF, 0xF, false));
                                P2[bj][e2] = __int_as_float(__builtin_amdgcn_mov_dpp(__float_as_int(s2), 0x122, 0xF, 0xF, false)); } }
                        const f32x4 cg = bgk + wgk[0] * P2[0] + wgk[1] * P1[0] + wgk[2] * X[0]; const f32x4 cv = bvk + wvk[0] * P2[1] + wvk[1] * P1[1] + wvk[2] * X[1];
                        const f32x4 y = (cg + (cg * cg) * cg * 0.044715f) * (-2.3022082f);
                        f32x4 o;
#pragma unroll
                        for (int e2 = 0; e2 < 4; ++e2) o[e2] = cg[e2] * __builtin_amdgcn_rcpf(1.0f + __builtin_amdgcn_exp2f(y[e2])) * cv[e2];
                        if (r >= 2 && t < ldg) { typedef unsigned u32x2v __attribute__((ext_vector_type(2))); u32x2v w; w.x = cvt_pk_bf16(o[0], o[1]); w.y = cvt_pk_bf16(o[2], o[3]); *(u32x2v*)(O + (size_t)t * ldc + gcol + 4 * n) = w; } }
            }
        } else
        if (mode_ == 0) {
#pragma unroll
            for (int ai = 0; ai < 2; ++ai)
#pragma unroll
                for (int m = 0; m < 4; ++m) { bf16_t* rowp = O + (size_t)(row0 + ai * HALF + m * 16) * ldc + col0;
#pragma unroll
                    for (int bj = 0; bj < 2; ++bj) { const f32x4 v0 = acc[ai][bj][m][0], v1 = acc[ai][bj][m][1];
                        u32x4 w; w.x = cvt_pk_bf16(v0[0], v0[1]); w.y = cvt_pk_bf16(v0[2], v0[3]); w.z = cvt_pk_bf16(v1[0], v1[1]); w.w = cvt_pk_bf16(v1[2], v1[3]);
                        *(u32x4*)(rowp + bj * HALF) = w; } }
        }
    }
};
template <class Epi, class Sched, bool ALIGN_EPI = false, bool SP2 = false>
__device__ __forceinline__ void gemm_phase(PG8_LAS unsigned char* lds, const Gemm g, const Sched& S, const Epi& E, const int tid) {
    const int wid = __builtin_amdgcn_readfirstlane(tid >> 6), lane = tid & 63, wr = wid >> 2, wc = wid & 3, fr = lane & 15, fq = lane >> 4;
    const int K = g.K, nt = K / BK;
    unsigned voffA[2], voffB[2];
#pragma unroll
    for (int i = 0; i < 2; ++i) { int R, C; stage_rc(tid * 16 + i * 8192, R, C); const int Rb = Epi::PERM ? ((R & ~31) + perm32(R & 31)) : R;
        voffA[i] = (unsigned)(R * K + C) * 2u; voffB[i] = (unsigned)(Rb * K + C) * 2u; }
    const size_t kstep = (size_t)(BK * 2);
    const size_t hstep = (size_t)HALF * K * 2;
    const size_t tstep = 2 * hstep;
    const size_t tstepA = (size_t)g.a_rows * K * 2;
    const unsigned ldsw = (unsigned)wid * 1024u;
    const int aoff = lds_byte(wr * 64 + fr, fq * 8), boff = lds_byte(wc * 32 + fr, fq * 8);
#define PG8_SA(b, h) (((b) * 2 + (h)) * HTB)
#define PG8_SB(b, h) ((4 + (b) * 2 + (h)) * HTB)
#define PG8_STAGE(bufoff, gbase, voff) do { _Pragma("unroll") for (int _i = 0; _i < 2; ++_i) \
        __builtin_amdgcn_global_load_lds((const unsigned*)((const char*)(gbase) + (voff)[_i]), (PG8_LAS unsigned*)(lds + (bufoff) + ldsw + _i * 8192), 16, 0, 0); } while (0)
#define PG8_LDA(dst, b, h) do { _Pragma("unroll") for (int m = 0; m < 4; ++m) _Pragma("unroll") for (int k = 0; k < 2; ++k) dst[m][k] = *(const PG8_LAS bf16x8*)(lds + PG8_SA(b, h) + aoff + m * 2048 + k * 1024); } while (0)
#define PG8_LDB(dst, b, h) do { _Pragma("unroll") for (int n = 0; n < 2; ++n) _Pragma("unroll") for (int k = 0; k < 2; ++k) dst[n][k] = *(const PG8_LAS bf16x8*)(lds + PG8_SB(b, h) + boff + n * 2048 + k * 1024); } while (0)
#define PG8_MMA(ai, bj, At, Bt) do { __builtin_amdgcn_s_setprio(1); _Pragma("unroll") for (int m = 0; m < 4; ++m) _Pragma("unroll") for (int n = 0; n < 2; ++n) _Pragma("unroll") for (int k = 0; k < 2; ++k) \
        acc[ai][bj][m][n] = __builtin_amdgcn_mfma_f32_16x16x32_bf16(Bt[n][k], At[m][k], acc[ai][bj][m][n], 0, 0, 0); __builtin_amdgcn_s_setprio(0); } while (0)
#define PG8_WAIT_V(n) asm volatile("s_waitcnt vmcnt(" #n ")" ::: "memory")
#define PG8_WAIT_L(n) asm volatile("s_waitcnt lgkmcnt(" #n ")" ::: "memory")
#define PG8_BAR __builtin_amdgcn_s_barrier()
#define PG8_SCHED __builtin_amdgcn_sched_barrier(0)
    Unit cur, nxt; int ui = 0;
    if (!S.next(0, cur)) return;
    f32x4 acc[2][2][4][2];
#pragma unroll
    for (int a = 0; a < 2; ++a)
#pragma unroll
        for (int b = 0; b < 2; ++b)
#pragma unroll
            for (int m = 0; m < 4; ++m)
#pragma unroll
                for (int n = 0; n < 2; ++n) acc[a][b][m][n] = (f32x4){0.f, 0.f, 0.f, 0.f};
    bf16x8 At[4][2], B0[2][2], B1[2][2];
    const char* cA = (const char*)g.A + (size_t)cur.pm * tstepA; const char* cB = (const char*)g.Bt + (size_t)cur.pn * tstep;
    S.a_ready(cur);
    if constexpr (SP2) {
        PG8_STAGE(PG8_SB(0, 0), cB, voffB); PG8_STAGE(PG8_SB(0, 1), cB + hstep, voffB); PG8_STAGE(PG8_SA(0, 0), cA, voffA); PG8_STAGE(PG8_SA(0, 1), cA + hstep, voffA);
        if (wr == 1) PG8_BAR;
        PG8_WAIT_V(2); PG8_BAR;
        PG8_STAGE(PG8_SB(1, 0), cB + kstep, voffB); PG8_STAGE(PG8_SA(1, 0), cA + kstep, voffA); PG8_STAGE(PG8_SB(1, 1), cB + hstep + kstep, voffB);
        PG8_WAIT_V(6); PG8_BAR;
    } else {
        PG8_STAGE(PG8_SB(0, 0), cB, voffB); PG8_STAGE(PG8_SA(0, 0), cA, voffA); PG8_STAGE(PG8_SB(0, 1), cB + hstep, voffB); PG8_STAGE(PG8_SA(0, 1), cA + hstep, voffA);
        if (wr == 1) PG8_BAR;
        PG8_WAIT_V(4); PG8_BAR;
        PG8_STAGE(PG8_SB(1, 0), cB + kstep, voffB); PG8_STAGE(PG8_SA(1, 0), cA + kstep, voffA); PG8_STAGE(PG8_SB(1, 1), cB + hstep + kstep, voffB);
        PG8_WAIT_V(6); PG8_BAR;
    }
    for (;;) {
        const bool has_next = S.next(ui + 1, nxt);
        const char* nA = has_next ? (const char*)g.A + (size_t)nxt.pm * tstepA : cA; const char* nB = has_next ? (const char*)g.Bt + (size_t)nxt.pn * tstep : cB;
        for (int t = 0; t < nt; t += 2) {
            const bool last = (t == nt - 2);
            const char* a1 = cA + (size_t)(t + 1) * kstep;
            const char* a2 = last ? nA : cA + (size_t)(t + 2) * kstep; const char* b2 = last ? nB : cB + (size_t)(t + 2) * kstep;
            const char* a3 = a2 + kstep; const char* b3 = b2 + kstep;
            if (last && has_next) S.a_ready(nxt);
            if constexpr (SP2) {
            PG8_LDB(B0, 0, 0); PG8_LDB(B1, 0, 1); PG8_SCHED; PG8_LDA(At, 0, 0); PG8_STAGE(PG8_SA(1, 1), a1 + hstep, voffA);
            PG8_WAIT_V(8); PG8_WAIT_L(0); PG8_BAR; PG8_MMA(0, 0, At, B0); PG8_MMA(0, 1, At, B1); PG8_BAR; PG8_SCHED;
            PG8_LDA(At, 0, 1); PG8_STAGE(PG8_SB(0, 0), b2, voffB); PG8_STAGE(PG8_SB(0, 1), b2 + hstep, voffB); PG8_STAGE(PG8_SA(0, 0), a2, voffA);
            PG8_WAIT_V(8); PG8_WAIT_L(0); PG8_BAR; PG8_MMA(1, 0, At, B0); PG8_MMA(1, 1, At, B1); PG8_BAR; PG8_SCHED;
            PG8_LDB(B0, 1, 0); PG8_LDB(B1, 1, 1); PG8_SCHED; PG8_LDA(At, 1, 0); PG8_STAGE(PG8_SA(0, 1), a2 + hstep, voffA);
            PG8_WAIT_V(8); PG8_WAIT_L(0); PG8_BAR; PG8_MMA(0, 0, At, B0); PG8_MMA(0, 1, At, B1); PG8_BAR; PG8_SCHED;
            PG8_LDA(At, 1, 1); PG8_STAGE(PG8_SB(1, 0), b3, voffB); PG8_STAGE(PG8_SB(1, 1), b3 + hstep, voffB); PG8_STAGE(PG8_SA(1, 0), a3, voffA);
            PG8_WAIT_V(8); PG8_WAIT_L(0); PG8_BAR; PG8_MMA(1, 0, At, B0); PG8_MMA(1, 1, At, B1); PG8_BAR; PG8_SCHED;
            } else {
            PG8_LDB(B0, 0, 0); PG8_SCHED; PG8_LDA(At, 0, 0); PG8_STAGE(PG8_SA(1, 1), a1 + hstep, voffA);
            PG8_WAIT_L(8); PG8_BAR; PG8_WAIT_L(0); PG8_MMA(0, 0, At, B0); PG8_BAR; PG8_SCHED;
            PG8_LDB(B1, 0, 1); PG8_STAGE(PG8_SB(0, 0), b2, voffB);
            PG8_BAR; PG8_WAIT_L(0); PG8_MMA(0, 1, At, B1); PG8_BAR;
            PG8_LDA(At, 0, 1); PG8_STAGE(PG8_SA(0, 0), a2, voffA);
            PG8_BAR; PG8_WAIT_L(0); PG8_MMA(1, 0, At, B0); PG8_BAR; PG8_SCHED;
            PG8_STAGE(PG8_SB(0, 1), b2 + hstep, voffB);
            PG8_WAIT_V(6); PG8_BAR; PG8_MMA(1, 1, At, B1); PG8_BAR;
            PG8_LDB(B0, 1, 0); PG8_SCHED; PG8_LDA(At, 1, 0); PG8_STAGE(PG8_SA(0, 1), a2 + hstep, voffA);
            PG8_WAIT_L(8); PG8_BAR; PG8_WAIT_L(0); PG8_MMA(0, 0, At, B0); PG8_BAR; PG8_SCHED;
            PG8_LDB(B1, 1, 1); PG8_STAGE(PG8_SB(1, 0), b3, voffB);
            PG8_BAR; PG8_WAIT_L(0); PG8_MMA(0, 1, At, B1); PG8_BAR;
            PG8_LDA(At, 1, 1); PG8_STAGE(PG8_SA(1, 0), a3, voffA);
            PG8_BAR; PG8_WAIT_L(0); PG8_MMA(1, 0, At, B0); PG8_BAR; PG8_SCHED;
            PG8_STAGE(PG8_SB(1, 1), b3 + hstep, voffB);
            PG8_WAIT_V(6); PG8_BAR; PG8_MMA(1, 1, At, B1); PG8_BAR;
            }
        }
        if constexpr (ALIGN_EPI) { if (wr == 0) PG8_BAR; }
        if constexpr (!Epi::AFTER_DRAIN) { E(acc, cur, wr, wc, fr, fq); S.done(cur); }
        if (!has_next) break;
        if (!E.keep(cur)) {
#pragma unroll
        for (int a = 0; a < 2; ++a)
#pragma unroll
            for (int b = 0; b < 2; ++b)
#pragma unroll
                for (int m = 0; m < 4; ++m)
#pragma unroll
                    for (int n = 0; n < 2; ++n) acc[a][b][m][n] = (f32x4){0.f, 0.f, 0.f, 0.f};
        }
        cur = nxt; cA = nA; cB = nB; ++ui;
        if constexpr (ALIGN_EPI) { if (wr == 1) PG8_BAR; }
    }
    PG8_WAIT_V(0);
    if constexpr (!ALIGN_EPI) { if (wr == 0) PG8_BAR; }
    PG8_BAR;
    if constexpr (Epi::AFTER_DRAIN) { E.fused(acc, cur, wr, wc, fr, fq, lds, wid, lane); S.done(cur); }
#undef PG8_SA
#undef PG8_SB
#undef PG8_STAGE
#undef PG8_LDA
#undef PG8_LDB
#undef PG8_MMA
#undef PG8_WAIT_V
#undef PG8_WAIT_L
#undef PG8_BAR
#undef PG8_SCHED
}
}
constexpr int T = 16384, D = 1024, NSRC = 5904, NIN = 6144, FF = 2816, NUP = 5632, DEPTH = 4;
constexpr int PQ = 0, PK = 256, PV = 512, PLG = 1024, PR = 1280, SQ = 1792, SK = 2304, SV = 2432, PU = 2560, PG = 3072;
constexpr float EPS = 1e-6f;
constexpr size_t MiB = 1u << 20;
constexpr size_t WS_WIN = 0, WS_WUP = 12 * MiB, WS_WDN = 23 * MiB, WS_WB = 29 * MiB  , WS_WOUT = 32 * MiB;
constexpr size_t WS_B2 = 34 * MiB;
constexpr size_t WS_H = WS_B2, WS_YG = WS_B2 + 32 * MiB, WS_YS = WS_B2 + 48 * MiB, WS_YP = WS_B2 + 64 * MiB, WS_UT = WS_B2 + 80 * MiB, WS_SB = WS_B2 + 112 * MiB, WS_AD = WS_B2 + 128 * MiB;
constexpr size_t WS_ACT = WS_B2 + 33 * MiB;
constexpr size_t WS_B1 = 164 * MiB;
constexpr size_t WS_CTL = WS_B1 + 192 * MiB;
constexpr size_t WS_END = WS_CTL + 1 * MiB;
constexpr int LDS_BYTES = 147456;

#define GAS __attribute__((address_space(1)))
#define LAS __attribute__((address_space(3)))
typedef unsigned short bf16;
typedef unsigned v4u __attribute__((ext_vector_type(4)));
typedef unsigned v2u __attribute__((ext_vector_type(2)));
typedef float f32x4 __attribute__((ext_vector_type(4)));
typedef short bf16x8 __attribute__((ext_vector_type(8)));
typedef short s16x4 __attribute__((ext_vector_type(4)));
#define LDS_WAIT() asm volatile("s_waitcnt lgkmcnt(0)" ::: "memory")

__device__ __forceinline__ unsigned pk2(float lo, float hi) { return pg8::cvt_pk_bf16(lo, hi); }
__device__ __forceinline__ float bflo(unsigned u) { return __uint_as_float(u << 16); }
__device__ __forceinline__ float bfhi(unsigned u) { return __uint_as_float(u & 0xffff0000u); }
__device__ __forceinline__ void unpack8(const v4u v, float* f) { f[0] = bflo(v.x); f[1] = bfhi(v.x); f[2] = bflo(v.y); f[3] = bfhi(v.y); f[4] = bflo(v.z); f[5] = bfhi(v.z); f[6] = bflo(v.w); f[7] = bfhi(v.w); }
__device__ __forceinline__ v4u pack8(const float* f) { v4u o; o.x = pk2(f[0], f[1]); o.y = pk2(f[2], f[3]); o.z = pk2(f[4], f[5]); o.w = pk2(f[6], f[7]); return o; }
__device__ __forceinline__ float shfl_idx(float v, int src) { return __int_as_float(__builtin_amdgcn_ds_bpermute(src << 2, __float_as_int(v))); }
__device__ __forceinline__ float wave_sum(float v, int lane) {
#pragma unroll
    for (int o = 1; o < 64; o <<= 1) v += shfl_idx(v, lane ^ o);
    return v;
}
__device__ __forceinline__ float lsig(float x) { return fminf(x, 0.f) - __logf(1.0f + __expf(-fabsf(x))); }
__device__ __forceinline__ f32x4 mfma16(bf16x8 a, bf16x8 b, f32x4 c) { return __builtin_amdgcn_mfma_f32_16x16x32_bf16(a, b, c, 0, 0, 0); }

struct Args { const float* in[20]; float* out; unsigned char* ws; };

struct TrDesc { const float* W; bf16* Wt; int N, K, k0, s0, d0; float scale; };
__device__ __forceinline__ void tr_load(const TrDesc& t, f32x4 (&v)[16], int lane) {
    const int kr = lane >> 4, c4 = (lane & 15) * 4;
#pragma unroll
    for (int i = 0; i < 16; ++i) v[i] = *(const f32x4*)(t.W + (size_t)(t.k0 + 4 * i + kr) * t.N + t.s0 + c4);
}
__device__ __forceinline__ void tr_finish(const TrDesc& t, const f32x4 (&v)[16], LAS float* scr, int lane) {
    const int kr = lane >> 4, c4 = (lane & 15) * 4;
#pragma unroll
    for (int i = 0; i < 16; ++i) { LAS float* d = scr + (4 * i + kr) * 65 + c4; d[0] = v[i][0] * t.scale; d[1] = v[i][1] * t.scale; d[2] = v[i][2] * t.scale; d[3] = v[i][3] * t.scale; }
    LDS_WAIT();
    const int c = lane & 7;
#pragma unroll
    for (int j = 0; j < 8; ++j) { const int n = (lane >> 3) + 8 * j; const LAS float* s = scr + (8 * c) * 65 + n;
        v4u o; o.x = pk2(s[0 * 65], s[1 * 65]); o.y = pk2(s[2 * 65], s[3 * 65]); o.z = pk2(s[4 * 65], s[5 * 65]); o.w = pk2(s[6 * 65], s[7 * 65]);
        *(v4u*)(t.Wt + (size_t)(t.d0 + n) * t.K + t.k0 + 8 * c) = o; }
    LDS_WAIT();
}
__device__ __forceinline__ void prep_weights(const Args& a, int l, LAS unsigned char* lds, int G, int bid, int tid) {
    const int wave = tid >> 6, lane = tid & 63;
    LAS float* scr = (LAS float*)(lds + wave * 16640);
    const int gw = bid * 8 + wave, NGW = G * 8;
    unsigned char* ws = a.ws;
    const float* w_in = a.in[5] + (size_t)l * D * NSRC;
    const float* w_up = a.in[16] + (size_t)l * D * NUP;
    const float* w_dn = a.in[19] + (size_t)l * FF * D;
    const float* w_bg = a.in[12] + (size_t)l * 512 * D;
    const float* w_bs = a.in[13] + (size_t)l * 512 * D;
    const float* w_bp = a.in[14] + (size_t)l * 512 * D;
    const float* w_out = a.in[15] + (size_t)l * D * D;
    bf16* Win_t = (bf16*)(ws + WS_WIN); bf16* Wup_t = (bf16*)(ws + WS_WUP); bf16* Wdn_t = (bf16*)(ws + WS_WDN); bf16* Wb_t = (bf16*)(ws + WS_WB); bf16* Wout_t = (bf16*)(ws + WS_WOUT);
    auto decode = [&](int it) -> TrDesc { TrDesc t; int r = it;
        if (r < 1472) { const int nb = r >> 4, kb = r & 15; const int d0 = 64 * (nb < 16 ? nb : nb + 4);
            t = TrDesc{w_in, Win_t, NSRC, D, 64 * kb, d0 < 1024 ? d0 : d0 - 240, d0, (d0 < 256 || (d0 >= SQ && d0 < SK)) ? 0.125f : 1.0f}; return t; }
        r -= 1472;
        if (r < 1408) { const int nb = r >> 4, kb = r & 15; const int j = nb >> 2, q = nb & 3;
            t = TrDesc{w_up, Wup_t, NUP, D, 64 * kb, q < 2 ? 128 * j + 64 * q : FF + 128 * j + 64 * (q - 2), 64 * nb, 1.0f}; return t; }
        r -= 1408;
        if (r < 704) { const int nb = r / 44, kb = r % 44; t = TrDesc{w_dn, Wdn_t, D, FF, 64 * kb, 64 * nb, 64 * nb, 1.0f}; return t; }
        r -= 704;
        if (r < 128) { const int nb = r >> 3, kb = r & 7; t = TrDesc{w_bg, Wb_t, D, 512, 64 * kb, 64 * nb, 64 * nb, 1.0f}; return t; }
        r -= 128;
        if (r < 128) { const int nb = r >> 3, kb = r & 7; t = TrDesc{w_bs, Wb_t + 1024 * 512, D, 512, 64 * kb, 64 * nb, 64 * nb, 1.0f}; return t; }
        r -= 128;
        { const int nb = r >> 4, kb = r & 15; t = TrDesc{w_out, Wout_t, D, D, 64 * kb, 64 * nb, 64 * nb, 1.0f}; return t; } };
    for (int it = gw; it < 4096; it += 2 * NGW) {
        const bool two = it + NGW < 4096;
        const TrDesc t0 = decode(it), t1 = decode(two ? it + NGW : it);
        f32x4 v0[16], v1[16];
        tr_load(t0, v0, lane); if (two) tr_load(t1, v1, lane);
        tr_finish(t0, v0, scr, lane); if (two) tr_finish(t1, v1, scr, lane);
    }
    const int gt = bid * 512 + tid, GT = G * 512;
    { const float* wgu = a.in[6] + (size_t)l * 16 * 256;
      for (int q = gt; q < 256 * 128; q += GT) { const int n = q & 255, kc = q >> 8;
          float wg[16];
#pragma unroll
          for (int r = 0; r < 16; ++r) wg[r] = wgu[r * 256 + n];
          float o[8];
#pragma unroll
          for (int e = 0; e < 8; ++e) { const f32x4* src = (const f32x4*)(w_in + (size_t)(8 * kc + e) * NSRC + 1024); float s = 0.f;
#pragma unroll
              for (int r4 = 0; r4 < 4; ++r4) { const f32x4 v = src[r4]; s += v[0] * wg[4 * r4] + v[1] * wg[4 * r4 + 1] + v[2] * wg[4 * r4 + 2] + v[3] * wg[4 * r4 + 3]; }
              o[e] = s; }
          *(v4u*)(Win_t + (size_t)(PLG + n) * D + 8 * kc) = pack8(o); } }
    { const float* pw = a.in[10] + (size_t)l * 4 * 128 * 128; const float* psc = a.in[11] + (size_t)l * 512; bf16* Wp_t = Wb_t + 2 * 1024 * 512;
      for (int q = gt; q < 1024 * 128; q += GT) { const int n = q & 1023, cc = __builtin_amdgcn_readfirstlane(q >> 10); const int g = cc >> 5, c0 = (cc & 31) * 4;
          const float* pwr = pw + ((size_t)g * 128 + c0) * 128; const float* wb = w_bp + (size_t)(128 * g) * D + n; const float* sc = psc + 128 * g;
#pragma unroll
          for (int r = 0; r < 4; ++r) { scr[r * 128 + lane] = pwr[r * 128 + lane]; scr[r * 128 + 64 + lane] = pwr[r * 128 + 64 + lane]; }
          scr[512 + lane] = sc[lane]; scr[512 + 64 + lane] = sc[64 + lane];
          LDS_WAIT();
          float o0 = 0.f, o1 = 0.f, o2 = 0.f, o3 = 0.f;
#pragma unroll 8
          for (int d = 0; d < 128; d += 4) { const f32x4 s4 = *(const LAS f32x4*)(scr + 512 + d);
              const f32x4 p0 = *(const LAS f32x4*)(scr + d), p1 = *(const LAS f32x4*)(scr + 128 + d), p2 = *(const LAS f32x4*)(scr + 256 + d), p3 = *(const LAS f32x4*)(scr + 384 + d);
              const float w0 = s4[0] * wb[(size_t)(d + 0) * D], w1 = s4[1] * wb[(size_t)(d + 1) * D], w2 = s4[2] * wb[(size_t)(d + 2) * D], w3 = s4[3] * wb[(size_t)(d + 3) * D];
              o0 += p0[0] * w0 + p0[1] * w1 + p0[2] * w2 + p0[3] * w3; o1 += p1[0] * w0 + p1[1] * w1 + p1[2] * w2 + p1[3] * w3;
              o2 += p2[0] * w0 + p2[1] * w1 + p2[2] * w2 + p2[3] * w3; o3 += p3[0] * w0 + p3[1] * w1 + p3[2] * w2 + p3[3] * w3; }
          LDS_WAIT();
          v2u w; w.x = pk2(o0, o1); w.y = pk2(o2, o3); *(v2u*)(Wp_t + (size_t)n * 512 + 128 * g + c0) = w; } }
}

__device__ __forceinline__ void rows_norm_first(const float* __restrict__ x, const float* __restrict__ g, bf16* __restrict__ h, int gw, int NGW, int lane) {
    f32x4 gv[4];
#pragma unroll
    for (int j = 0; j < 4; ++j) gv[j] = ((const f32x4*)g)[lane + 64 * j];
    for (int m = gw; m < T; m += NGW) {
        const f32x4* xr = (const f32x4*)(x + (size_t)m * D) + lane; f32x4 v[4]; float s = 0.f;
#pragma unroll
        for (int j = 0; j < 4; ++j) { v[j] = xr[64 * j]; s += (v[j].x * v[j].x + v[j].y * v[j].y) + (v[j].z * v[j].z + v[j].w * v[j].w); }
        const float rs = rsqrtf(wave_sum(s, lane) * (1.f / D) + EPS);
        v2u* o = (v2u*)(h + (size_t)m * D) + lane;
#pragma unroll
        for (int j = 0; j < 4; ++j) { v2u w; w.x = pk2(v[j].x * rs * gv[j].x, v[j].y * rs * gv[j].y); w.y = pk2(v[j].z * rs * gv[j].z, v[j].w * rs * gv[j].w); o[64 * j] = w; }
    }
}
__device__ __forceinline__ void rows_residual(const bf16* __restrict__ ob, const float* xin, float* xout, const float* __restrict__ gpost, const float* __restrict__ gnext, bf16* __restrict__ h, bf16* hzero, int gw, int NGW, int lane) {
    f32x4 gp[4], gn[4];
#pragma unroll
    for (int j = 0; j < 4; ++j) { gp[j] = ((const f32x4*)gpost)[lane + 64 * j]; gn[j] = gnext ? ((const f32x4*)gnext)[lane + 64 * j] : (f32x4){0.f, 0.f, 0.f, 0.f}; }
    if (hzero && gw == 0) { unsigned zz = 0u; asm volatile("" : "+v"(zz)); v4u z; z.x = zz; z.y = zz; z.z = zz; z.w = zz;
#pragma unroll
        for (int j = 0; j < 4; ++j) ((v4u*)hzero)[lane + 64 * j] = z; }
    for (int m0 = gw; m0 < T; m0 += 2 * NGW) {
        f32x4 ov[2][4], xv[2][4]; float s[2] = {0.f, 0.f};
#pragma unroll
        for (int rr = 0; rr < 2; ++rr) { const int m = m0 + rr * NGW; const v2u* orow = (const v2u*)(ob + (size_t)m * D) + lane; const f32x4* xr = (const f32x4*)(xin + (size_t)m * D) + lane;
#pragma unroll
            for (int j = 0; j < 4; ++j) { const v2u w = orow[64 * j]; xv[rr][j] = xr[64 * j]; ov[rr][j] = (f32x4){bflo(w.x), bfhi(w.x), bflo(w.y), bfhi(w.y)}; } }
#pragma unroll
        for (int rr = 0; rr < 2; ++rr)
#pragma unroll
            for (int j = 0; j < 4; ++j) s[rr] += (ov[rr][j].x * ov[rr][j].x + ov[rr][j].y * ov[rr][j].y) + (ov[rr][j].z * ov[rr][j].z + ov[rr][j].w * ov[rr][j].w);
#pragma unroll
        for (int o = 1; o < 64; o <<= 1) { const float t0 = shfl_idx(s[0], lane ^ o), t1 = shfl_idx(s[1], lane ^ o); s[0] += t0; s[1] += t1; }
        float s2[2] = {0.f, 0.f};
#pragma unroll
        for (int rr = 0; rr < 2; ++rr) { const int m = m0 + rr * NGW; const float rs = rsqrtf(s[rr] * (1.f / D) + EPS); f32x4* xo = (f32x4*)(xout + (size_t)m * D) + lane;
#pragma unroll
            for (int j = 0; j < 4; ++j) { xv[rr][j] = xv[rr][j] + ov[rr][j] * rs * gp[j]; xo[64 * j] = xv[rr][j];
                s2[rr] += (xv[rr][j].x * xv[rr][j].x + xv[rr][j].y * xv[rr][j].y) + (xv[rr][j].z * xv[rr][j].z + xv[rr][j].w * xv[rr][j].w); } }
        if (gnext) {
#pragma unroll
            for (int o = 1; o < 64; o <<= 1) { const float t0 = shfl_idx(s2[0], lane ^ o), t1 = shfl_idx(s2[1], lane ^ o); s2[0] += t0; s2[1] += t1; }
#pragma unroll
            for (int rr = 0; rr < 2; ++rr) { const int m = m0 + rr * NGW; const float r2 = rsqrtf(s2[rr] * (1.f / D) + EPS); v2u* o = (v2u*)(h + (size_t)m * D) + lane;
#pragma unroll
                for (int j = 0; j < 4; ++j) { v2u w; w.x = pk2(xv[rr][j].x * r2 * gn[j].x, xv[rr][j].y * r2 * gn[j].y); w.y = pk2(xv[rr][j].z * r2 * gn[j].z, xv[rr][j].w * r2 * gn[j].w); o[64 * j] = w; } } }
    }
}
__device__ __forceinline__ void swa_phase(LAS unsigned char* lds, const bf16* __restrict__ proj, const float* __restrict__ sinks, bf16* __restrict__ ys, int G, int bid, int tid) {
    LAS bf16* Ks = (LAS bf16*)lds; LAS bf16* VT = (LAS bf16*)(lds + 36864);
    const int wave = tid >> 6, lane = tid & 63, fr = lane & 15, fq = lane >> 4;
    for (int u = bid; u < 256; u += G) {
        const int nb = u >> 1, kh = u & 1;
#pragma unroll
        for (int i = 0; i < 4; ++i) { const int p = tid + 512 * i; const int row = p >> 3, ch = p & 7; int t = 128 * nb - 128 + row; if (t < 0) t += 128;
            const v4u kv = *(const v4u*)(proj + (size_t)t * NIN + SK + 64 * kh + 8 * ch); *(LAS v4u*)(Ks + row * 72 + 8 * ch) = kv; }
#pragma unroll
        for (int i = 0; i < 4; ++i) { const int p = tid + 512 * i; const int key = p & 255, ch = p >> 8; int t = 128 * nb - 128 + key; if (t < 0) t += 128;
            const v4u vv = *(const v4u*)(proj + (size_t)t * NIN + SV + 64 * kh + 8 * ch);
            LAS bf16* vp = VT + (8 * ch) * 264 + key;
            vp[0 * 264] = (bf16)(vv.x & 0xffffu); vp[1 * 264] = (bf16)(vv.x >> 16); vp[2 * 264] = (bf16)(vv.y & 0xffffu); vp[3 * 264] = (bf16)(vv.y >> 16);
            vp[4 * 264] = (bf16)(vv.z & 0xffffu); vp[5 * 264] = (bf16)(vv.z >> 16); vp[6 * 264] = (bf16)(vv.w & 0xffffu); vp[7 * 264] = (bf16)(vv.w >> 16); }
        __syncthreads();
        const int rb = __builtin_amdgcn_readfirstlane(wave); const size_t trow = (size_t)(128 * nb + 16 * rb + fr);
        bf16x8 q0 = *(const bf16x8*)(proj + trow * NIN + SQ + 64 * (4 * kh) + 8 * fq), q1 = *(const bf16x8*)(proj + trow * NIN + SQ + 64 * (4 * kh) + 32 + 8 * fq);
#pragma unroll 1
        for (int g = 0; g < 4; ++g) {
            const int hq = 4 * kh + g; const int hn = 4 * kh + (g < 3 ? g + 1 : 3);
            const bf16x8 qn0 = *(const bf16x8*)(proj + trow * NIN + SQ + 64 * hn + 8 * fq), qn1 = *(const bf16x8*)(proj + trow * NIN + SQ + 64 * hn + 32 + 8 * fq);
            f32x4 s[9];
#pragma unroll
            for (int j = 0; j < 9; ++j) { const LAS bf16* kp = Ks + (16 * (rb + j) + fr) * 72 + 8 * fq;
                const bf16x8 k0 = *(const LAS bf16x8*)kp, k1 = *(const LAS bf16x8*)(kp + 32);
                s[j] = mfma16(k0, q0, (f32x4){0.f, 0.f, 0.f, 0.f}); s[j] = mfma16(k1, q1, s[j]); }
            const int dd = 4 * fq - fr; const int jmin = nb > 0 ? 0 : 8 - rb;
            float mx = -1e30f;
#pragma unroll
            for (int j = 0; j < 9; ++j)
#pragma unroll
                for (int r = 0; r < 4; ++r) { bool ok = j >= jmin; if (j == 0) ok = ok && (dd + r >= 1); if (j == 8) ok = ok && (dd + r <= 0);
                    s[j][r] = ok ? s[j][r] : -1e30f; mx = fmaxf(mx, s[j][r]); }
            mx = fmaxf(mx, shfl_idx(mx, lane ^ 16)); mx = fmaxf(mx, shfl_idx(mx, lane ^ 32));
            const float sk = sinks[hq]; mx = fmaxf(mx, sk);
            float sum = 0.f;
#pragma unroll
            for (int j = 0; j < 9; ++j)
#pragma unroll
                for (int r = 0; r < 4; ++r) { const float p = s[j][r] > -1e29f ? __expf(s[j][r] - mx) : 0.f; s[j][r] = p; sum += p; }
            sum += shfl_idx(sum, lane ^ 16); sum += shfl_idx(sum, lane ^ 32);
            const float inv = 1.0f / (sum + __expf(sk - mx));
            bf16x8 pf[5];
#pragma unroll
            for (int jj = 0; jj < 5; ++jj) { const f32x4 a = s[2 * jj] * inv; const f32x4 b = jj < 4 ? s[2 * jj + 1] * inv : (f32x4){0.f, 0.f, 0.f, 0.f};
                v4u w; w.x = pk2(a[0], a[1]); w.y = pk2(a[2], a[3]); w.z = pk2(b[0], b[1]); w.w = pk2(b[2], b[3]); pf[jj] = __builtin_bit_cast(bf16x8, w); }
#pragma unroll
            for (int nt = 0; nt < 4; ++nt) { f32x4 o = {0.f, 0.f, 0.f, 0.f}; const LAS bf16* vp = VT + (16 * nt + fr) * 264 + 16 * rb + 4 * fq;
#pragma unroll
                for (int jj = 0; jj < 5; ++jj) { const int j0 = 2 * jj, j1 = jj < 4 ? 2 * jj + 1 : 8;
                    const v2u lo = *(const LAS v2u*)(vp + 16 * j0), hi = *(const LAS v2u*)(vp + 16 * j1);
                    v4u av; av.x = lo.x; av.y = lo.y; av.z = hi.x; av.w = hi.y;
                    o = mfma16(__builtin_bit_cast(bf16x8, av), pf[jj], o); }
                v2u w; w.x = pk2(o[0], o[1]); w.y = pk2(o[2], o[3]);
                *(v2u*)(ys + trow * 512 + 64 * hq + 16 * nt + 4 * fq) = w; }
            q0 = qn0; q1 = qn1;
        }
        __syncthreads();
    }
}

__device__ __forceinline__ void pool_phase(const bf16* __restrict__ proj, bf16* __restrict__ dp, int gw, int NGW, int lane) {
    const int w = 2 << (lane >> 4);
    const bf16* up = proj + PU + 8 * lane;
    for (int task = gw; task < 2048; task += NGW) {
        const int t0 = task * 8;
        float s[8] = {0.f, 0.f, 0.f, 0.f, 0.f, 0.f, 0.f, 0.f};
#pragma unroll
        for (int k = 1; k < 16; ++k) { if (k < w && t0 - k >= 0) { float f[8]; unpack8(*(const v4u*)(up + (size_t)(t0 - k) * NIN), f);
#pragma unroll
                for (int e = 0; e < 8; ++e) s[e] += f[e]; } }
#pragma unroll
        for (int r = 0; r < 8; ++r) { const int t = t0 + r; float f[8]; unpack8(*(const v4u*)(up + (size_t)t * NIN), f);
            const float ic = 1.0f / (float)(t + 1 < w ? t + 1 : w); float o[8];
#pragma unroll
            for (int e = 0; e < 8; ++e) { s[e] += f[e]; o[e] = s[e] * ic - f[e]; }
            *(v4u*)(dp + (size_t)t * 512 + 8 * lane) = pack8(o);
            const int tl = t - w + 1;
            if (tl >= 0) { float g[8]; unpack8(*(const v4u*)(up + (size_t)tl * NIN), g);
#pragma unroll
                for (int e = 0; e < 8; ++e) s[e] -= g[e]; } }
    }
}

__device__ __forceinline__ void lane_scan8(float* v, int lane) {
#pragma unroll
    for (int off = 1; off < 64; off <<= 1) {
#pragma unroll
        for (int e = 0; e < 8; ++e) { const float t = shfl_idx(v[e], lane - off); v[e] += (lane >= off) ? t : 0.f; } }
}
__device__ __forceinline__ void glaa_phase(LAS unsigned char* lds, const bf16* __restrict__ proj, const float* __restrict__ bgate, float* __restrict__ UT, float* __restrict__ AD, int G, int bid, int tid) {
    const int qd = tid >> 7, hw = (tid >> 6) & 1, lane = tid & 63, fr = lane & 15, fq = lane >> 4;
    LAS bf16* KT = (LAS bf16*)(lds + qd * 27648); LAS bf16* VT = KT + 64 * 72;
    for (int it = bid; it < 256; it += G) {
        const int u = 4 * it + qd; const int h = u & 3;
        const bf16* rowp = proj + (size_t)(64 * (u >> 2) + lane) * NIN;
#pragma unroll
        for (int ii = 0; ii < 4; ++ii) { const int db = hw * 4 + ii;
            float b[8]; { float f[8]; unpack8(*(const v4u*)(rowp + PLG + 64 * h + 8 * db), f);
#pragma unroll
                for (int e = 0; e < 8; ++e) b[e] = lsig(f[e] + bgate[64 * h + 8 * db + e]) * 0.0625f; }
            lane_scan8(b, lane);
            float kf[8]; unpack8(*(const v4u*)(rowp + PK + 64 * h + 8 * db), kf);
#pragma unroll
            for (int e = 0; e < 8; ++e) { const float bl = __int_as_float(__builtin_amdgcn_readlane(__float_as_int(b[e]), 63)); const float kt = kf[e] * __expf(bl - b[e]);
                KT[(8 * db + e) * 72 + lane] = (bf16)(pk2(kt, 0.f) & 0xffffu);
                if (lane == 63) AD[(size_t)u * 64 + 8 * db + e] = __expf(bl); } }
#pragma unroll
        for (int i = 0; i < 8; ++i) { const int ch = hw * 8 + i; const v4u vv = *(const v4u*)(rowp + PV + 128 * h + 8 * ch);
            LAS bf16* vp = VT + (8 * ch) * 72 + lane;
            vp[0 * 72] = (bf16)(vv.x & 0xffffu); vp[1 * 72] = (bf16)(vv.x >> 16); vp[2 * 72] = (bf16)(vv.y & 0xffffu); vp[3 * 72] = (bf16)(vv.y >> 16);
            vp[4 * 72] = (bf16)(vv.z & 0xffffu); vp[5 * 72] = (bf16)(vv.z >> 16); vp[6 * 72] = (bf16)(vv.w & 0xffffu); vp[7 * 72] = (bf16)(vv.w >> 16); }
        __syncthreads();
#pragma unroll
        for (int nn = 0; nn < 4; ++nn) { const int nt = 4 * hw + nn;
            const LAS bf16* bp = VT + (16 * nt + fr) * 72 + 8 * fq; const bf16x8 b0 = *(const LAS bf16x8*)bp, b1 = *(const LAS bf16x8*)(bp + 32);
#pragma unroll
            for (int mt = 0; mt < 4; ++mt) { const LAS bf16* ap = KT + (16 * mt + fr) * 72 + 8 * fq; const bf16x8 a0 = *(const LAS bf16x8*)ap, a1 = *(const LAS bf16x8*)(ap + 32);
                f32x4 acc = mfma16(a0, b0, (f32x4){0.f, 0.f, 0.f, 0.f}); acc = mfma16(a1, b1, acc);
                *(f32x4*)(UT + ((size_t)u * 128 + 16 * nt + fr) * 64 + 16 * mt + 4 * fq) = acc; } }
        __syncthreads();
    }
}
__device__ __forceinline__ void gla_scan_phase(LAS unsigned char* lds, const float* __restrict__ UT, const float* __restrict__ AD, bf16* __restrict__ SB, int G, int bid, int tid) {
    LAS f32x4* SL = (LAS f32x4*)lds;
    const int egl = tid & 31, seg = tid >> 5;
    for (int blk = bid; blk < 256; blk += G) {
        const int e0 = (blk * 32 + egl) * 4; const int ai0 = (e0 >> 13) * 64 + (e0 & 63);
        const float* up = UT + (size_t)(seg * 16) * 32768 + e0; const float* ap = AD + (seg * 16) * 256 + ai0;
        f32x4 uu[16], aa[16];
#pragma unroll
        for (int i = 0; i < 16; ++i) { uu[i] = *(const f32x4*)(up + (size_t)i * 32768); aa[i] = *(const f32x4*)(ap + i * 256); }
        f32x4 S = {0.f, 0.f, 0.f, 0.f}, Pp = {1.f, 1.f, 1.f, 1.f};
#pragma unroll
        for (int i = 0; i < 16; ++i) { S = aa[i] * S + uu[i]; Pp = Pp * aa[i]; }
        SL[seg * 32 + egl] = S; SL[512 + seg * 32 + egl] = Pp;
        __syncthreads();
        f32x4 C = {0.f, 0.f, 0.f, 0.f};
#pragma unroll 1
        for (int s = 0; s < seg; ++s) C = SL[512 + s * 32 + egl] * C + SL[s * 32 + egl];
        S = C;
        bf16* sp = SB + (size_t)(seg * 16) * 32768 + e0;
#pragma unroll
        for (int i = 0; i < 16; ++i) { v2u w; w.x = pk2(S[0], S[1]); w.y = pk2(S[2], S[3]); *(v2u*)(sp + (size_t)i * 32768) = w; S = aa[i] * S + uu[i]; }
        __syncthreads();
    }
}
__device__ __forceinline__ void glac_phase(LAS unsigned char* lds, const bf16* __restrict__ proj, const bf16* __restrict__ SB, const float* __restrict__ bgate, const float* __restrict__ gnorm, bf16* __restrict__ yg, int G, int bid, int tid) {
    const int half = tid >> 8, hw = (tid >> 6) & 3, lane = tid & 63, fr = lane & 15, fq = lane >> 4;
    LAS bf16* Qs = (LAS bf16*)(lds + half * 36864); LAS bf16* Ks = Qs + 64 * 72; LAS bf16* VT = Ks + 64 * 72;
    for (int it = bid; it < 512; it += G) {
        const int u = 2 * it + half; const int c = u >> 2, h = u & 3;
        const bf16* rowp = proj + (size_t)(64 * c + lane) * NIN;
#pragma unroll
        for (int ii = 0; ii < 2; ++ii) { const int db = hw * 2 + ii;
            float b[8]; { float f[8]; unpack8(*(const v4u*)(rowp + PLG + 64 * h + 8 * db), f);
#pragma unroll
                for (int e = 0; e < 8; ++e) b[e] = lsig(f[e] + bgate[64 * h + 8 * db + e]) * 0.0625f; }
            lane_scan8(b, lane);
            float qf[8], kf[8]; unpack8(*(const v4u*)(rowp + PQ + 64 * h + 8 * db), qf); unpack8(*(const v4u*)(rowp + PK + 64 * h + 8 * db), kf);
#pragma unroll
            for (int e = 0; e < 8; ++e) { const float eb = __expf(b[e]); qf[e] *= eb; kf[e] *= __builtin_amdgcn_rcpf(eb); }
            *(LAS v4u*)(Qs + lane * 72 + 8 * db) = pack8(qf); *(LAS v4u*)(Ks + lane * 72 + 8 * db) = pack8(kf); }
#pragma unroll
        for (int i = 0; i < 4; ++i) { const int ch = hw * 4 + i; const v4u vv = *(const v4u*)(rowp + PV + 128 * h + 8 * ch);
            LAS bf16* vp = VT + (8 * ch) * 72 + lane;
            vp[0 * 72] = (bf16)(vv.x & 0xffffu); vp[1 * 72] = (bf16)(vv.x >> 16); vp[2 * 72] = (bf16)(vv.y & 0xffffu); vp[3 * 72] = (bf16)(vv.y >> 16);
            vp[4 * 72] = (bf16)(vv.z & 0xffffu); vp[5 * 72] = (bf16)(vv.z >> 16); vp[6 * 72] = (bf16)(vv.w & 0xffffu); vp[7 * 72] = (bf16)(vv.w >> 16); }
        __syncthreads();
        const LAS bf16* qp = Qs + (16 * hw + fr) * 72 + 8 * fq; const bf16x8 q0 = *(const LAS bf16x8*)qp, q1 = *(const LAS bf16x8*)(qp + 32);
        f32x4 s[4];
#pragma unroll
        for (int jt = 0; jt < 4; ++jt) { const LAS bf16* kp = Ks + (16 * jt + fr) * 72 + 8 * fq; const bf16x8 k0 = *(const LAS bf16x8*)kp, k1 = *(const LAS bf16x8*)(kp + 32);
            s[jt] = mfma16(k0, q0, (f32x4){0.f, 0.f, 0.f, 0.f}); s[jt] = mfma16(k1, q1, s[jt]);
#pragma unroll
            for (int r = 0; r < 4; ++r) s[jt][r] = (16 * jt + 4 * fq + r <= 16 * hw + fr) ? s[jt][r] : 0.f; }
        bf16x8 pf[2];
#pragma unroll
        for (int jj = 0; jj < 2; ++jj) { v4u w; w.x = pk2(s[2 * jj][0], s[2 * jj][1]); w.y = pk2(s[2 * jj][2], s[2 * jj][3]); w.z = pk2(s[2 * jj + 1][0], s[2 * jj + 1][1]); w.w = pk2(s[2 * jj + 1][2], s[2 * jj + 1][3]); pf[jj] = __builtin_bit_cast(bf16x8, w); }
        f32x4 o[8]; float ss = 0.f;
#pragma unroll
        for (int nt = 0; nt < 8; ++nt) { const LAS bf16* vp = VT + (16 * nt + fr) * 72 + 4 * fq;
            const v2u a0 = *(const LAS v2u*)vp, a1 = *(const LAS v2u*)(vp + 16), a2 = *(const LAS v2u*)(vp + 32), a3 = *(const LAS v2u*)(vp + 48);
            v4u A0; A0.x = a0.x; A0.y = a0.y; A0.z = a1.x; A0.w = a1.y; v4u A1; A1.x = a2.x; A1.y = a2.y; A1.z = a3.x; A1.w = a3.y;
            const bf16* sp = SB + ((size_t)u * 128 + 16 * nt + fr) * 64 + 8 * fq; const bf16x8 S0 = *(const bf16x8*)sp, S1 = *(const bf16x8*)(sp + 32);
            f32x4 acc = mfma16(__builtin_bit_cast(bf16x8, A0), pf[0], (f32x4){0.f, 0.f, 0.f, 0.f}); acc = mfma16(__builtin_bit_cast(bf16x8, A1), pf[1], acc);
            acc = mfma16(S0, q0, acc); acc = mfma16(S1, q1, acc); o[nt] = acc;
            ss += (acc[0] * acc[0] + acc[1] * acc[1]) + (acc[2] * acc[2] + acc[3] * acc[3]); }
        ss += shfl_idx(ss, lane ^ 16); ss += shfl_idx(ss, lane ^ 32);
        const float rinv = rsqrtf(ss * (1.0f / 128.0f) + EPS);
        const size_t trow = (size_t)(64 * c + 16 * hw + fr);
#pragma unroll
        for (int nt = 0; nt < 8; ++nt) { const int n = 128 * h + 16 * nt + 4 * fq; const f32x4 gn = *(const f32x4*)(gnorm + n);
            const v2u rv = *(const v2u*)(proj + trow * NIN + PR + n); const float rr[4] = {bflo(rv.x), bfhi(rv.x), bflo(rv.y), bfhi(rv.y)}; float ov[4];
#pragma unroll
            for (int e = 0; e < 4; ++e) ov[e] = o[nt][e] * rinv * gn[e] * rr[e] * __builtin_amdgcn_rcpf(1.0f + __expf(-rr[e]));
            v2u w; w.x = pk2(ov[0], ov[1]); w.y = pk2(ov[2], ov[3]); *(v2u*)(yg + trow * 512 + n) = w; }
        __syncthreads();
    }
}
struct Ptrs { bf16 *Win_t, *Wup_t, *Wdn_t, *Wb_t, *Wout_t, *hbuf, *yg, *ysw, *yp, *SB, *act, *proj; float *UT, *AD; };
__device__ __forceinline__ Ptrs mkptrs(unsigned char* ws) { Ptrs P;
    P.Win_t = (bf16*)(ws + WS_WIN); P.Wup_t = (bf16*)(ws + WS_WUP); P.Wdn_t = (bf16*)(ws + WS_WDN); P.Wb_t = (bf16*)(ws + WS_WB); P.Wout_t = (bf16*)(ws + WS_WOUT);
    P.hbuf = (bf16*)(ws + WS_H); P.yg = (bf16*)(ws + WS_YG); P.ysw = (bf16*)(ws + WS_YS); P.yp = (bf16*)(ws + WS_YP); P.UT = (float*)(ws + WS_UT); P.SB = (bf16*)(ws + WS_SB); P.AD = (float*)(ws + WS_AD);
    P.act = (bf16*)(ws + WS_ACT); P.proj = (bf16*)(ws + WS_B1); return P; }
__device__ __forceinline__ void load_args(Args& a, const __attribute__((address_space(4))) Args* p) {
#pragma unroll
    for (int i = 0; i < 20; ++i) a.in[i] = p->in[i];
    a.out = p->out; a.ws = p->ws; }
#define XB_TMO      128
#define XB_XCNT(j)  (256  + 64 * (j))
#define XB_XSUB(j)  (1280 + 64 * (j))
#define XB_XGEN(j)  (2304 + 64 * (j))
#define XB_TOP      3328
#define XB_TOPGEN   3392
#define XCD_BAR_WORDS 3456
#define XB_SPIN_CAP (1u << 18)

__device__ __forceinline__ unsigned xb_ld(unsigned* p)              { return __hip_atomic_load(p, __ATOMIC_RELAXED, __HIP_MEMORY_SCOPE_AGENT); }
__device__ __forceinline__ unsigned xb_add(unsigned* p, unsigned v) { return __hip_atomic_fetch_add(p, v, __ATOMIC_RELAXED, __HIP_MEMORY_SCOPE_AGENT); }
__device__ __forceinline__ unsigned xb_xcc_id() { return (unsigned)__builtin_amdgcn_s_getreg((3 << 11) | 20) & 0xFu; }
#define XB_SPIN(cond, bar) do { unsigned _sp = 0; while (cond) { \
    if ((++_sp & 255u) == 0u) { if (xb_ld(&(bar)[XB_TMO])) break; if (_sp > XB_SPIN_CAP) { atomicAdd(&(bar)[XB_TMO], 1u); break; } } } } while (0)
__device__ __forceinline__ void grid_bar(unsigned* bar, volatile LAS unsigned* st, unsigned G, int wave, int lane) {
    asm volatile("s_waitcnt vmcnt(0)" ::: "memory");
    __syncthreads();
    if (wave == 0 && lane == 0) {
        const unsigned x = xb_xcc_id();
        __builtin_amdgcn_s_waitcnt(0);
        unsigned nloc = st[0], nx = st[1];
        if (nloc == 0u) {
            unsigned sum, cnt, mine, sp = 0u;
            for (;;) { sum = 0u; cnt = 0u; mine = 0u;
#pragma unroll
                for (unsigned j = 0; j < 16; ++j) { const unsigned c = xb_ld(&bar[XB_XCNT(j)]); sum += c; cnt += (c > 0u) ? 1u : 0u; mine = (j == x) ? c : mine; }
                if (sum == G) break;
                __builtin_amdgcn_s_sleep(1);
                if ((++sp & 255u) == 0u) { if (xb_ld(&bar[XB_TMO])) break; if (sp > XB_SPIN_CAP) { atomicAdd(&bar[XB_TMO], 1u); break; } } }
            nloc = mine > 0u ? mine : 1u; nx = cnt > 0u ? cnt : 1u; st[0] = nloc; st[1] = nx; }
        const unsigned old = xb_add(&bar[XB_XSUB(x)], 1u);
        const unsigned gen = old / nloc;
        if (old + 1u == (gen + 1u) * nloc) {
            __builtin_amdgcn_fence(__ATOMIC_RELEASE, "agent");
            asm volatile("s_waitcnt vmcnt(0)" ::: "memory");
            const unsigned og = xb_add(&bar[XB_TOP], 1u);
            const unsigned tg = og / nx;
            if (og + 1u == (tg + 1u) * nx) xb_add(&bar[XB_TOPGEN], 1u);
            else XB_SPIN(xb_ld(&bar[XB_TOPGEN]) == tg, bar);
            __builtin_amdgcn_fence(__ATOMIC_ACQUIRE, "agent");
            xb_add(&bar[XB_XGEN(x)], 1u);
            asm volatile("s_waitcnt vmcnt(0)" ::: "memory");
        } else {
            XB_SPIN(xb_ld(&bar[XB_XGEN(x)]) == gen, bar);
            __builtin_amdgcn_fence(__ATOMIC_ACQUIRE, "agent");
            asm volatile("s_waitcnt vmcnt(0)" ::: "memory");
        }
    }
    __syncthreads();
}
#define PHASE_VARS() int bid = bid0; asm volatile("" : "+s"(bid)); int G = G0; asm volatile("" : "+s"(G)); int wv_ = wave0; asm volatile("" : "+s"(wv_)); const int wave = wv_; \
    int ln_; asm volatile("v_mbcnt_lo_u32_b32 %0, -1, 0\n\tv_mbcnt_hi_u32_b32 %0, -1, %0" : "=v"(ln_)); const int lane = ln_; const int tid = wave * 64 + lane; \
    const __attribute__((address_space(4))) Args* ap_ = (const __attribute__((address_space(4))) Args*)__builtin_amdgcn_kernarg_segment_ptr(); asm volatile("" : "+s"(ap_)); \
    Args a; load_args(a, ap_); float* xout = a.out; (void)xout; const Ptrs P = mkptrs(a.ws); \
    const int gw = bid * 8 + wave, NGW = G * 8, gt = bid * 512 + tid, GT = G * 512; (void)gw; (void)NGW; (void)gt; (void)GT
__global__ void __launch_bounds__(512, 2) mk_fwd(Args a_unused) {
    extern __shared__ __attribute__((aligned(16))) unsigned char lds_raw[];
    LAS unsigned char* lds = (LAS unsigned char*)lds_raw;
    const int G0 = gridDim.x, bid0 = blockIdx.x;
    const int wave0 = __builtin_amdgcn_readfirstlane(threadIdx.x >> 6);
    if (blockIdx.x == 0) for (int i = threadIdx.x; i < XCD_BAR_WORDS; i += 512) __hip_atomic_store((unsigned*)(a_unused.ws + WS_CTL) + i, 0u, __ATOMIC_RELAXED, __HIP_MEMORY_SCOPE_AGENT);
    if (threadIdx.x < 2) ((LAS unsigned*)(lds + LDS_BYTES - 16))[threadIdx.x] = 0u;
    cg::this_grid().sync();
    if (threadIdx.x == 0) (void)xb_add((unsigned*)(a_unused.ws + WS_CTL) + XB_XCNT(xb_xcc_id()), 1u);
#define GRID_SYNC() do { PHASE_VARS(); grid_bar((unsigned*)(a.ws + WS_CTL), (volatile LAS unsigned*)(lds + LDS_BYTES - 16), (unsigned)G, wave, lane); } while (0)
#pragma unroll 1
    for (int l = -1; l < DEPTH; ++l) {
#pragma unroll 1
        for (int step = l < 0 ? 12 : 0; step < 13; ++step) {
            if (step == 5 || step == 6 || step == 10) continue;
            if ((0x0A91 >> step) & 1) {
              { PHASE_VARS();
                const bf16* A = P.hbuf; const bf16* Bt = P.Win_t; int N = NIN, K = D; pg8::EpiUni E{0, P.proj, NIN, nullptr, NIN, nullptr, nullptr, lds + 131072};
                int tri = 0, a_rows = 256, Mr = T;
                if (step == 4) { A = P.yg; Bt = P.Wb_t; N = D; K = 512; tri = 1; E = pg8::EpiUni{3, P.hbuf, D, P.proj + PG, NIN, nullptr, nullptr, lds + 131072}; }
                else if (step == 7) { A = P.hbuf; Bt = P.Wout_t; N = D; K = D; E = pg8::EpiUni{0, P.proj, D, nullptr, NIN, nullptr, nullptr, lds + 131072}; }
                else if (step == 9) { A = P.hbuf; Bt = P.Wup_t; N = NUP; K = D; a_rows = 254; Mr = 65 * 256; E = pg8::EpiUni{5, P.act, FF, nullptr, T, a.in[17] + (size_t)l * 3 * NUP, a.in[18] + (size_t)l * NUP, lds + 131072}; }
                else if (step == 11) { A = P.act; Bt = P.Wdn_t; N = D; K = FF; E = pg8::EpiUni{0, P.proj, D, nullptr, NIN, nullptr, nullptr, lds + 131072}; }
                pg8::Gemm g{A, Bt, Mr, N, K, a_rows}; pg8::StaticOrder S; S.init(Mr, N, G, bid); S.tri = tri;
                pg8::gemm_phase<pg8::EpiUni, pg8::StaticOrder, true, true>(lds, g, S, E, tid); }
            } else if (step == 1) {
                { PHASE_VARS(); swa_phase(lds, P.proj, a.in[9] + l * 8, P.ysw, G, bid, tid); }
                { PHASE_VARS(); pool_phase(P.proj, P.yp, gw, NGW, lane); }
                { PHASE_VARS(); glaa_phase(lds, P.proj, a.in[7] + l * 256, P.UT, P.AD, G, bid, tid); }
            } else if (step == 2) { PHASE_VARS(); gla_scan_phase(lds, P.UT, P.AD, P.SB, G, bid, tid);
            } else if (step == 3) { PHASE_VARS(); glac_phase(lds, P.proj, P.SB, a.in[7] + l * 256, a.in[8] + l * 512, P.yg, G, bid, tid);
            } else {
#pragma unroll 1
                for (int pass = 0; pass < 2; ++pass) {
                    PHASE_VARS();
                    const bool do_prep = (pass == 0) != ((wave & 1) != 0);
                    if (do_prep) { if (step == 12 && l + 1 < DEPTH) prep_weights(a, l + 1, lds, G, bid, tid); }
                    else if (l < 0) rows_norm_first(a.in[0], a.in[1], P.hbuf, gw, NGW, lane);
                    else { const bool r1 = step == 8;
                        const float* xin = (r1 && l == 0) ? a.in[0] : xout; const float* gpost = (r1 ? a.in[2] : a.in[4]) + l * D;
                        const float* gnext = r1 ? a.in[3] + l * D : (l + 1 < DEPTH ? a.in[1] + (l + 1) * D : nullptr);
                        rows_residual(P.proj, xin, xout, gpost, gnext, r1 ? P.hbuf + 2 * D : P.hbuf, r1 ? P.hbuf : nullptr, gw, NGW, lane); }
                }
            }
            GRID_SYNC();
        }
    }
}

extern "C" void kernel_launch(void* const* d_in, const int* in_sizes, int n_in, void* d_out, int out_size, void* d_ws, size_t ws_size, hipStream_t stream) {
    static int grid = 0;
    if (grid == 0) {
        if (n_in != 20 || out_size != T * D || ws_size < WS_END) { fprintf(stderr, "kernel_launch: unexpected shapes (n_in %d out %d ws %zu, need %zu)\n", n_in, out_size, ws_size, (size_t)WS_END); grid = -1; return; }
        int dev = 0, cus = 0, per_cu = 0;
        (void)hipGetDevice(&dev); (void)hipDeviceGetAttribute(&cus, hipDeviceAttributeMultiprocessorCount, dev);
        (void)hipFuncSetAttribute((const void*)mk_fwd, hipFuncAttributeMaxDynamicSharedMemorySize, LDS_BYTES);
        if (hipOccupancyMaxActiveBlocksPerMultiprocessor(&per_cu, (const void*)mk_fwd, 512, LDS_BYTES) != hipSuccess || per_cu < 1) per_cu = 1;
        (void)hipGetLastError();
        grid = cus * per_cu;
        fprintf(stderr, "kernel_launch: grid %d (cus %d x %d), ws %zu\n", grid, cus, per_cu, ws_size);
    }
    if (grid < 0) return;
    Args a{};
    for (int i = 0; i < 20; ++i) a.in[i] = (const float*)d_in[i];
    a.out = (float*)d_out; a.ws = (unsigned char*)d_ws;
    void* args[] = {&a};
    hipError_t e = hipLaunchCooperativeKernel((void*)mk_fwd, dim3(grid), dim3(512), args, LDS_BYTES, stream);
    if (e != hipSuccess) fprintf(stderr, "cooperative launch failed: %s (grid %d)\n", hipGetErrorString(e), grid);
}
```
